# Optimizing an MI355X kernel written in HIP

```python
import jax, jax.numpy as jnp
from jax import lax
import numpy as np

D_MODEL = 1024
BATCH = 32
SEQ = 2048
DEPTH = 1

N_META = 16
Q_BLOCK = 128
EPS = 1e-6
FOX_HEADS = 8
FOX_HEAD_DIM = 64
FOX_W = FOX_HEADS * FOX_HEAD_DIM
MLA_HEADS = 8
MLA_Q_RANK = 256
MLA_KV_RANK = 128
MLA_NOPE_DIM = 64
MLA_ROPE_DIM = 32
MLA_QK_DIM = MLA_NOPE_DIM + MLA_ROPE_DIM
MLA_V_DIM = 64
MLA_W = MLA_HEADS * MLA_V_DIM
ROPE_THETA = 10000.0
D_FF = 2816
N_BRANCH = 2
IN_SIZES = (FOX_W, FOX_W, FOX_W, FOX_HEADS, MLA_Q_RANK, MLA_KV_RANK, MLA_ROPE_DIM, N_BRANCH * D_MODEL)
IN_W = FOX_W * 3 + FOX_HEADS + MLA_Q_RANK + MLA_KV_RANK + MLA_ROPE_DIM + N_BRANCH * D_MODEL

kernel_name = "hybrid_fox_mla_macaron_meta"


def rms_norm(x, gain):
    xf = x.astype(jnp.float32)
    y = xf * lax.rsqrt(jnp.mean(xf * xf, axis=-1, keepdims=True) + EPS)
    return (y * gain.astype(jnp.float32)).astype(x.dtype)


def swiglu_ffn(u, w_gu, w_down):
    g, up = jnp.split(u @ w_gu, 2, axis=-1)
    return (jax.nn.silu(g) * up) @ w_down


def rope(x, cos, sin):
    xf = x.astype(jnp.float32)
    x1, x2 = jnp.split(xf, 2, axis=-1)
    out = jnp.concatenate([x1 * cos - x2 * sin, x1 * sin + x2 * cos], axis=-1)
    return out.astype(x.dtype)


def block_causal_attention(q, k, v, log_forget_cum=None):
    L = q.shape[2]
    scale = q.shape[-1] ** -0.5
    bounds = [(0, N_META)] + [(N_META + i * Q_BLOCK, N_META + (i + 1) * Q_BLOCK)
                              for i in range((L - N_META) // Q_BLOCK)]
    outs = []
    for qs, qe in bounds:
        qb = q[:, :, qs:qe].astype(jnp.float32)
        kb = k[:, :, :qe].astype(jnp.float32)
        s = jnp.einsum("bhqd,bhkd->bhqk", qb, kb) * scale
        if log_forget_cum is not None:
            s = s + log_forget_cum[:, :, qs:qe, None] - log_forget_cum[:, :, None, :qe]
        mask = jnp.arange(qs, qe)[:, None] >= jnp.arange(qe)[None, :]
        p = jax.nn.softmax(jnp.where(mask, s, -jnp.inf), axis=-1)
        outs.append(jnp.einsum("bhqk,bhkd->bhqd", p.astype(v.dtype), v[:, :, :qe]))
    return jnp.concatenate(outs, axis=2)


def split_heads(t, n_heads):
    B, L, _ = t.shape
    return t.reshape(B, L, n_heads, -1).transpose(0, 2, 1, 3)


def merge_heads(t):
    B, H, L, dh = t.shape
    return t.transpose(0, 2, 1, 3).reshape(B, L, H * dh)


def token_mixing(u, w_in, b_forget, b_gate, fox_q_norm, fox_k_norm, mla_cq_norm, mla_w_uq,
                 mla_ckv_norm, mla_w_ukv, mla_q_norm, mla_k_norm, w_branch_fox, w_branch_mla,
                 w_out):
    B, L, _ = u.shape
    cuts = list(np.cumsum(IN_SIZES)[:-1])
    fq, fk, fv, f_logit, c_q, c_kv, k_rope, gate_logit = jnp.split(u @ w_in, cuts, axis=-1)

    fq = rms_norm(split_heads(fq, FOX_HEADS), fox_q_norm)
    fk = rms_norm(split_heads(fk, FOX_HEADS), fox_k_norm)
    fv = split_heads(fv, FOX_HEADS)
    log_f = jax.nn.log_sigmoid(f_logit.astype(jnp.float32) + b_forget.astype(jnp.float32))
    log_f_cum = jnp.cumsum(log_f.transpose(0, 2, 1), axis=-1)
    o_fox = merge_heads(block_causal_attention(fq, fk, fv, log_f_cum)) @ w_branch_fox

    q = split_heads(rms_norm(c_q, mla_cq_norm) @ mla_w_uq, MLA_HEADS)
    kv = split_heads(rms_norm(c_kv, mla_ckv_norm) @ mla_w_ukv, MLA_HEADS)
    k_nope, v = jnp.split(kv, [MLA_NOPE_DIM], axis=-1)
    k_rope_h = jnp.broadcast_to(k_rope[:, None], (B, MLA_HEADS, L, MLA_ROPE_DIM))
    k = jnp.concatenate([k_nope, k_rope_h], axis=-1)
    q = rms_norm(q, mla_q_norm)
    k = rms_norm(k, mla_k_norm)
    pos = jnp.arange(L, dtype=jnp.float32)
    inv_freq = ROPE_THETA ** (-jnp.arange(0, MLA_ROPE_DIM, 2, dtype=jnp.float32) / MLA_ROPE_DIM)
    ang = pos[:, None] * inv_freq[None, :]
    cos, sin = jnp.cos(ang), jnp.sin(ang)
    q = jnp.concatenate([q[..., :MLA_NOPE_DIM], rope(q[..., MLA_NOPE_DIM:], cos, sin)], axis=-1)
    k = jnp.concatenate([k[..., :MLA_NOPE_DIM], rope(k[..., MLA_NOPE_DIM:], cos, sin)], axis=-1)
    o_mla = merge_heads(block_causal_attention(q, k, v)) @ w_branch_mla

    g_fox, g_mla = jnp.split(jax.nn.sigmoid(gate_logit + b_gate), N_BRANCH, axis=-1)
    return (g_fox * o_fox + g_mla * o_mla) @ w_out


def setup_inputs(seed: int = 0) -> dict:
    key = jax.random.key(seed)
    ks = iter(jax.random.split(key, 32))

    def w(shape, fan_in):
        return jax.random.normal(next(ks), shape, jnp.float32) * fan_in ** -0.5

    def gain(shape):
        return 1.0 + 0.1 * jax.random.normal(next(ks), shape, jnp.float32)

    def bias(shape, scale=0.1, center=0.0):
        return center + scale * jax.random.normal(next(ks), shape, jnp.float32)

    Dp = DEPTH
    return {
        "x": jax.random.normal(next(ks), (BATCH, SEQ, D_MODEL), jnp.float32),
        "meta_tokens": jax.random.normal(next(ks), (N_META, D_MODEL), jnp.float32),
        "ffn1_norm": gain((Dp, D_MODEL)),
        "ffn1_w_gu": w((Dp, D_MODEL, 2 * D_FF), D_MODEL),
        "ffn1_w_down": w((Dp, D_FF, D_MODEL), D_FF),
        "mix_norm": gain((Dp, D_MODEL)),
        "w_in": w((Dp, D_MODEL, IN_W), D_MODEL),
        "b_forget": bias((Dp, FOX_HEADS), 0.1, 2.0),
        "b_gate": bias((Dp, N_BRANCH * D_MODEL)),
        "fox_q_norm": gain((Dp, FOX_HEAD_DIM)),
        "fox_k_norm": gain((Dp, FOX_HEAD_DIM)),
        "mla_cq_norm": gain((Dp, MLA_Q_RANK)),
        "mla_w_uq": w((Dp, MLA_Q_RANK, MLA_HEADS * MLA_QK_DIM), MLA_Q_RANK),
        "mla_ckv_norm": gain((Dp, MLA_KV_RANK)),
        "mla_w_ukv": w((Dp, MLA_KV_RANK, MLA_HEADS * (MLA_NOPE_DIM + MLA_V_DIM)), MLA_KV_RANK),
        "mla_q_norm": gain((Dp, MLA_QK_DIM)),
        "mla_k_norm": gain((Dp, MLA_QK_DIM)),
        "w_branch_fox": w((Dp, FOX_W, D_MODEL), FOX_W),
        "w_branch_mla": w((Dp, MLA_W, D_MODEL), MLA_W),
        "w_out": w((Dp, D_MODEL, D_MODEL), D_MODEL),
        "ffn2_norm": gain((Dp, D_MODEL)),
        "ffn2_w_gu": w((Dp, D_MODEL, 2 * D_FF), D_MODEL),
        "ffn2_w_down": w((Dp, D_FF, D_MODEL), D_FF),
    }


def reference(x, meta_tokens, ffn1_norm, ffn1_w_gu, ffn1_w_down, mix_norm, w_in, b_forget, b_gate,
              fox_q_norm, fox_k_norm, mla_cq_norm, mla_w_uq, mla_ckv_norm, mla_w_ukv, mla_q_norm,
              mla_k_norm, w_branch_fox, w_branch_mla, w_out, ffn2_norm, ffn2_w_gu, ffn2_w_down):
    B = x.shape[0]
    meta = jnp.broadcast_to(meta_tokens.astype(x.dtype)[None], (B, N_META, D_MODEL))
    h = jnp.concatenate([meta, x], axis=1)
    for l in range(DEPTH):
        h = h + 0.5 * swiglu_ffn(rms_norm(h, ffn1_norm[l]), ffn1_w_gu[l], ffn1_w_down[l])
        h = h + token_mixing(rms_norm(h, mix_norm[l]), w_in[l], b_forget[l], b_gate[l],
                             fox_q_norm[l], fox_k_norm[l], mla_cq_norm[l], mla_w_uq[l],
                             mla_ckv_norm[l], mla_w_ukv[l], mla_q_norm[l], mla_k_norm[l],
                             w_branch_fox[l], w_branch_mla[l], w_out[l])
        h = h + 0.5 * swiglu_ffn(rms_norm(h, ffn2_norm[l]), ffn2_w_gu[l], ffn2_w_down[l])
    return h[:, N_META:]
```

```cpp
#include <hip/hip_runtime.h>
#include <hip/hip_cooperative_groups.h>
#include <cstdio>
#include <cstdint>
namespace cg = cooperative_groups;
#define MK_N_LAUNCHES 1
#define STOP_PHASE 12
#define SKIP_MASK 0
namespace pg8 {
#define PG8_LAS __attribute__((address_space(3)))
typedef unsigned short bf16_t;
typedef short bf16x8 __attribute__((ext_vector_type(8)));
typedef float f32x4 __attribute__((ext_vector_type(4)));
typedef unsigned u32x4 __attribute__((ext_vector_type(4)));
constexpr int BM = 256, BK = 64, HALF = 128, HTB = HALF * BK * 2  , STAGE_BYTES = 8 * HTB, NXCD = 8, WGM = 8;

__host__ __device__ __forceinline__ int lds_byte(int r, int c) { const int st = (r >> 4) * 2 + (c >> 5), rr = r & 15, cc = c & 31, ob = rr * 64 + cc * 2; return st * 1024 + (ob ^ (((ob >> 9) & 1) << 5)); }
__host__ __device__ __forceinline__ void stage_rc(int b, int& R, int& C) { const int st = b / 1024, sb = b % 1024, swz = sb ^ (((sb >> 9) & 1) << 5); R = (st >> 1) * 16 + swz / 64; C = (st & 1) * 32 + (swz % 64) / 2; }
__host__ __device__ __forceinline__ int perm32(int rho) { const int n = rho >> 4, i = rho & 15; return 8 * (i >> 2) + 4 * n + (i & 3); }

struct Unit { int pm, pn; };
struct Gemm { const bf16_t* A; const bf16_t* Bt; int M, N, K, lda; };

struct StaticOrder {
    int nM, nN, nwg, G, c;
    __host__ __device__ void init(int M, int N, int G_, int c_) { nM = M / BM; nN = N / BM; nwg = nM * nN; G = G_; c = c_; }
    __host__ __device__ bool next(int i, Unit& u) const {
        const long L = (long)i * G + c; if (L >= nwg) return false;
        int wgid = (int)L; { const int q = nwg / NXCD, r = nwg % NXCD, xcd = wgid % NXCD, off = wgid / NXCD; wgid = (xcd < r ? xcd * (q + 1) : r * (q + 1) + (xcd - r) * q) + off; }
        const int nig = WGM * nN, gid = wgid / nig, fm = gid * WGM, gsz = (nM - fm) < WGM ? (nM - fm) : WGM;
        u.pm = fm + ((wgid % nig) % gsz); u.pn = (wgid % nig) / gsz; return true;
    }
    __device__ __forceinline__ void a_ready(const Unit&) const {}
    __device__ __forceinline__ void done(const Unit&) const {}
};
__device__ __forceinline__ unsigned cvt_pk_bf16(float lo, float hi) { unsigned r; asm volatile("v_cvt_pk_bf16_f32 %0, %1, %2" : "=v"(r) : "v"(lo), "v"(hi)); return r; }
typedef float f32x2 __attribute__((ext_vector_type(2)));
template <class Epi, class Sched, bool ALIGN_EPI = false, bool SP2 = false>
__device__ __forceinline__ void gemm_phase(PG8_LAS unsigned char* lds, const Gemm g, const Sched& S, const Epi& E) {
    const int tid = threadIdx.x, wid = __builtin_amdgcn_readfirstlane(tid >> 6), lane = tid & 63, wr = wid >> 2, wc = wid & 3, fr = lane & 15, fq = lane >> 4;
    const int K = g.K, nt = K / BK;
    unsigned voffA[2], voffB[2];
#pragma unroll
    for (int i = 0; i < 2; ++i) { int R, C; stage_rc(tid * 16 + i * 8192, R, C); const int Rb = Epi::PERM ? ((R & ~31) + perm32(R & 31)) : R;
        voffA[i] = (unsigned)(R * g.lda + C) * 2u; voffB[i] = (unsigned)(Rb * K + C) * 2u; }
    const size_t kstep = (size_t)(BK * 2);
    const size_t hstep = (size_t)HALF * K * 2;
    const size_t tstep = 2 * hstep;
    const size_t hstepA = (size_t)HALF * g.lda * 2, tstepA = 2 * hstepA;
    const unsigned ldsw = (unsigned)wid * 1024u;
    const int aoff = lds_byte(wr * 64 + fr, fq * 8), boff = lds_byte(wc * 32 + fr, fq * 8);
#define PG8_SA(b, h) (((b) * 2 + (h)) * HTB)
#define PG8_SB(b, h) ((4 + (b) * 2 + (h)) * HTB)
#define PG8_STAGE(bufoff, gbase, voff) do { _Pragma("unroll") for (int _i = 0; _i < 2; ++_i) \
        __builtin_amdgcn_global_load_lds((const unsigned*)((const char*)(gbase) + (voff)[_i]), (PG8_LAS unsigned*)(lds + (bufoff) + ldsw + _i * 8192), 16, 0, 0); } while (0)
#define PG8_LDA(dst, b, h) do { _Pragma("unroll") for (int m = 0; m < 4; ++m) _Pragma("unroll") for (int k = 0; k < 2; ++k) dst[m][k] = *(const PG8_LAS bf16x8*)(lds + PG8_SA(b, h) + aoff + m * 2048 + k * 1024); } while (0)
#define PG8_LDB(dst, b, h) do { _Pragma("unroll") for (int n = 0; n < 2; ++n) _Pragma("unroll") for (int k = 0; k < 2; ++k) dst[n][k] = *(const PG8_LAS bf16x8*)(lds + PG8_SB(b, h) + boff + n * 2048 + k * 1024); } while (0)
#define PG8_MMA(ai, bj, At, Bt) do { __builtin_amdgcn_s_setprio(1); _Pragma("unroll") for (int m = 0; m < 4; ++m) _Pragma("unroll") for (int n = 0; n < 2; ++n) _Pragma("unroll") for (int k = 0; k < 2; ++k) \
        acc[ai][bj][m][n] = __builtin_amdgcn_mfma_f32_16x16x32_bf16(Bt[n][k], At[m][k], acc[ai][bj][m][n], 0, 0, 0); __builtin_amdgcn_s_setprio(0); } while (0)
#define PG8_WAIT_V(n) asm volatile("s_waitcnt vmcnt(" #n ")" ::: "memory")
#define PG8_WAIT_L(n) asm volatile("s_waitcnt lgkmcnt(" #n ")" ::: "memory")
#define PG8_BAR __builtin_amdgcn_s_barrier()
#define PG8_SCHED __builtin_amdgcn_sched_barrier(0)
    Unit cur, nxt; int ui = 0;
    if (!S.next(0, cur)) return;
    f32x4 acc[2][2][4][2];
#pragma unroll
    for (int a = 0; a < 2; ++a)
#pragma unroll
        for (int b = 0; b < 2; ++b)
#pragma unroll
            for (int m = 0; m < 4; ++m)
#pragma unroll
                for (int n = 0; n < 2; ++n) acc[a][b][m][n] = (f32x4){0.f, 0.f, 0.f, 0.f};
    bf16x8 At[4][2], B0[2][2], B1[2][2];
    const char* cA = (const char*)g.A + (size_t)cur.pm * tstepA; const char* cB = (const char*)g.Bt + (size_t)cur.pn * tstep;
    S.a_ready(cur);
    if constexpr (SP2) {
        PG8_STAGE(PG8_SB(0, 0), cB, voffB); PG8_STAGE(PG8_SB(0, 1), cB + hstep, voffB); PG8_STAGE(PG8_SA(0, 0), cA, voffA); PG8_STAGE(PG8_SA(0, 1), cA + hstepA, voffA);
        if (wr == 1) PG8_BAR;
        PG8_WAIT_V(2); PG8_BAR;
        PG8_STAGE(PG8_SB(1, 0), cB + kstep, voffB); PG8_STAGE(PG8_SA(1, 0), cA + kstep, voffA); PG8_STAGE(PG8_SB(1, 1), cB + hstep + kstep, voffB);
        PG8_WAIT_V(6); PG8_BAR;
    } else {
        PG8_STAGE(PG8_SB(0, 0), cB, voffB); PG8_STAGE(PG8_SA(0, 0), cA, voffA); PG8_STAGE(PG8_SB(0, 1), cB + hstep, voffB); PG8_STAGE(PG8_SA(0, 1), cA + hstepA, voffA);
        if (wr == 1) PG8_BAR;
        PG8_WAIT_V(4); PG8_BAR;
        PG8_STAGE(PG8_SB(1, 0), cB + kstep, voffB); PG8_STAGE(PG8_SA(1, 0), cA + kstep, voffA); PG8_STAGE(PG8_SB(1, 1), cB + hstep + kstep, voffB);
        PG8_WAIT_V(6); PG8_BAR;
    }
    for (;;) {
        const bool has_next = S.next(ui + 1, nxt);
        const char* nA = has_next ? (const char*)g.A + (size_t)nxt.pm * tstepA : cA; const char* nB = has_next ? (const char*)g.Bt + (size_t)nxt.pn * tstep : cB;
        for (int t = 0; t < nt; t += 2) {
            const bool last = (t == nt - 2);
            const char* a1 = cA + (size_t)(t + 1) * kstep;
            const char* a2 = last ? nA : cA + (size_t)(t + 2) * kstep; const char* b2 = last ? nB : cB + (size_t)(t + 2) * kstep;
            const char* a3 = a2 + kstep; const char* b3 = b2 + kstep;
            if (last && has_next) S.a_ready(nxt);
            if constexpr (SP2) {
            PG8_LDB(B0, 0, 0); PG8_LDB(B1, 0, 1); PG8_SCHED; PG8_LDA(At, 0, 0); PG8_STAGE(PG8_SA(1, 1), a1 + hstepA, voffA);
            PG8_WAIT_V(8); PG8_WAIT_L(0); PG8_BAR; PG8_MMA(0, 0, At, B0); PG8_MMA(0, 1, At, B1); PG8_BAR; PG8_SCHED;
            PG8_LDA(At, 0, 1); PG8_STAGE(PG8_SB(0, 0), b2, voffB); PG8_STAGE(PG8_SB(0, 1), b2 + hstep, voffB); PG8_STAGE(PG8_SA(0, 0), a2, voffA);
            PG8_WAIT_V(8); PG8_WAIT_L(0); PG8_BAR; PG8_MMA(1, 0, At, B0); PG8_MMA(1, 1, At, B1); PG8_BAR; PG8_SCHED;
            PG8_LDB(B0, 1, 0); PG8_LDB(B1, 1, 1); PG8_SCHED; PG8_LDA(At, 1, 0); PG8_STAGE(PG8_SA(0, 1), a2 + hstepA, voffA);
            PG8_WAIT_V(8); PG8_WAIT_L(0); PG8_BAR; PG8_MMA(0, 0, At, B0); PG8_MMA(0, 1, At, B1); PG8_BAR; PG8_SCHED;
            PG8_LDA(At, 1, 1); PG8_STAGE(PG8_SB(1, 0), b3, voffB); PG8_STAGE(PG8_SB(1, 1), b3 + hstep, voffB); PG8_STAGE(PG8_SA(1, 0), a3, voffA);
            PG8_WAIT_V(8); PG8_WAIT_L(0); PG8_BAR; PG8_MMA(1, 0, At, B0); PG8_MMA(1, 1, At, B1); PG8_BAR; PG8_SCHED;
            } else {
            PG8_LDB(B0, 0, 0); PG8_SCHED; PG8_LDA(At, 0, 0); PG8_STAGE(PG8_SA(1, 1), a1 + hstepA, voffA);
            PG8_WAIT_L(8); PG8_BAR; PG8_WAIT_L(0); PG8_MMA(0, 0, At, B0); PG8_BAR; PG8_SCHED;
            PG8_LDB(B1, 0, 1); PG8_STAGE(PG8_SB(0, 0), b2, voffB);
            PG8_BAR; PG8_WAIT_L(0); PG8_MMA(0, 1, At, B1); PG8_BAR;
            PG8_LDA(At, 0, 1); PG8_STAGE(PG8_SA(0, 0), a2, voffA);
            PG8_BAR; PG8_WAIT_L(0); PG8_MMA(1, 0, At, B0); PG8_BAR; PG8_SCHED;
            PG8_STAGE(PG8_SB(0, 1), b2 + hstep, voffB);
            PG8_WAIT_V(6); PG8_BAR; PG8_MMA(1, 1, At, B1); PG8_BAR;
            PG8_LDB(B0, 1, 0); PG8_SCHED; PG8_LDA(At, 1, 0); PG8_STAGE(PG8_SA(0, 1), a2 + hstepA, voffA);
            PG8_WAIT_L(8); PG8_BAR; PG8_WAIT_L(0); PG8_MMA(0, 0, At, B0); PG8_BAR; PG8_SCHED;
            PG8_LDB(B1, 1, 1); PG8_STAGE(PG8_SB(1, 0), b3, voffB);
            PG8_BAR; PG8_WAIT_L(0); PG8_MMA(0, 1, At, B1); PG8_BAR;
            PG8_LDA(At, 1, 1); PG8_STAGE(PG8_SA(1, 0), a3, voffA);
            PG8_BAR; PG8_WAIT_L(0); PG8_MMA(1, 0, At, B0); PG8_BAR; PG8_SCHED;
            PG8_STAGE(PG8_SB(1, 1), b3 + hstep, voffB);
            PG8_WAIT_V(6); PG8_BAR; PG8_MMA(1, 1, At, B1); PG8_BAR;
            }
        }
        if constexpr (ALIGN_EPI) { if (wr == 0) PG8_BAR; }
        if constexpr (!Epi::AFTER_DRAIN) { E(acc, cur, wr, wc, fr, fq); S.done(cur); }
        if (!has_next) break;
#pragma unroll
        for (int a = 0; a < 2; ++a)
#pragma unroll
            for (int b = 0; b < 2; ++b)
#pragma unroll
                for (int m = 0; m < 4; ++m)
#pragma unroll
                    for (int n = 0; n < 2; ++n) acc[a][b][m][n] = (f32x4){0.f, 0.f, 0.f, 0.f};
        cur = nxt; cA = nA; cB = nB; ++ui;
        if constexpr (ALIGN_EPI) { if (wr == 1) PG8_BAR; }
    }
    PG8_WAIT_V(0);
    if constexpr (!ALIGN_EPI) { if (wr == 0) PG8_BAR; }
    PG8_BAR;
    if constexpr (Epi::AFTER_DRAIN) { E.fused(acc, cur, wr, wc, fr, fq, lds, wid, lane); S.done(cur); }
#undef PG8_SA
#undef PG8_SB
#undef PG8_STAGE
#undef PG8_LDA
#undef PG8_LDB
#undef PG8_MMA
#undef PG8_WAIT_V
#undef PG8_WAIT_L
#undef PG8_BAR
#undef PG8_SCHED
}
}

constexpr int MROWS = 65536;
constexpr int MROWS1 = 65792;
constexpr int NMETA = 16, SEQ = 2048, DMODEL = 1024, DFF = 2816;
constexpr float EPS = 1e-6f;
constexpr float L2E = 1.4426950408889634f;

namespace epi {
using pg8::f32x4; using pg8::u32x4; using pg8::bf16_t; using pg8::Unit; using pg8::cvt_pk_bf16;
__device__ __forceinline__ u32x4 pack8(const f32x4 a, const f32x4 b) { u32x4 w; w.x = cvt_pk_bf16(a[0], a[1]); w.y = cvt_pk_bf16(a[2], a[3]); w.z = cvt_pk_bf16(b[0], b[1]); w.w = cvt_pk_bf16(b[2], b[3]); return w; }
__device__ __forceinline__ float sq4(const f32x4 a) { return (a[0] * a[0] + a[1] * a[1]) + (a[2] * a[2] + a[3] * a[3]); }
__device__ __forceinline__ float red_fq(float s) { s += __shfl_xor(s, 16); s += __shfl_xor(s, 32); return s; }
__device__ __forceinline__ float sigm(float z) { return __builtin_amdgcn_rcpf(1.f + __builtin_amdgcn_exp2f(-z * L2E)); }
__device__ __forceinline__ f32x4 bf4_to_f32(unsigned lo, unsigned hi) { f32x4 r; r[0] = __uint_as_float(lo << 16); r[1] = __uint_as_float(lo & 0xffff0000u); r[2] = __uint_as_float(hi << 16); r[3] = __uint_as_float(hi & 0xffff0000u); return r; }

template <int NP> __device__ __forceinline__ float ss_sum(const float* p, int row) {
    if (NP == 1) return p[row];
    float s = 0.f;
#pragma unroll
    for (int i = 0; i < NP / 4; ++i) { const f32x4 v = *(const f32x4*)(p + (size_t)row * NP + 4 * i); s += (v[0] + v[1]) + (v[2] + v[3]); }
    return s;
}

#define EPI_LAS __attribute__((address_space(3)))
struct RsTable { const EPI_LAS float* rs; const EPI_LAS int* pm; int cnt; const float* ssp; };
__device__ __forceinline__ float rs_lookup(const RsTable& t, int pm, int rin, int row) {
    int slot = -1;
    for (int k = 0; k < t.cnt; ++k) if (t.pm[k] == pm) slot = k;
    if (slot >= 0) return t.rs[slot * 256 + rin];
    return rsqrtf(ss_sum<16>(t.ssp, row) * (1.f / 1024.f) + EPS);
}

template <int NP> struct EpiSwiglu {
    static constexpr bool PERM = true, AFTER_DRAIN = false;
    bf16_t* O; int ldo; const float* ss; RsTable tab;
    __device__ __forceinline__ void operator()(const f32x4 (&acc)[2][2][4][2], const Unit& u, int wr, int wc, int fr, int fq) const {
        const int ocol = u.pn * 128 + wc * 32 + 8 * fq;
#pragma unroll
        for (int ai = 0; ai < 2; ++ai)
#pragma unroll
            for (int m = 0; m < 4; ++m) {
                const int row = u.pm * 256 + ai * 128 + wr * 64 + m * 16 + fr;
                const float rs = (NP == 0) ? 1.f : (NP < 0 ? rs_lookup(tab, u.pm, ai * 128 + wr * 64 + m * 16 + fr, row) : rsqrtf(ss_sum<(NP <= 0 ? 1 : NP)>(ss, row) * (1.f / 1024.f) + EPS));
                f32x4 h[2];
#pragma unroll
                for (int n = 0; n < 2; ++n) { const f32x4 g = acc[ai][0][m][n] * rs, up = acc[ai][1][m][n] * rs;
#pragma unroll
                    for (int i = 0; i < 4; ++i) h[n][i] = g[i] * sigm(g[i]) * up[i]; }
                *(u32x4*)(O + (size_t)row * ldo + ocol) = pack8(h[0], h[1]);
            }
    }
};

template <bool HALF, bool RESB, bool OUTF, bool HASB, bool HASSS> struct EpiRes {
    static constexpr bool PERM = true, AFTER_DRAIN = false;
    const float* resf; const bf16_t* resb; float* outf; bf16_t* outb; float* ss;
    __device__ __forceinline__ void operator()(const f32x4 (&acc)[2][2][4][2], const Unit& u, int wr, int wc, int fr, int fq) const {
        const float coef = HALF ? 0.5f : 1.0f;
#pragma unroll
        for (int ai = 0; ai < 2; ++ai)
#pragma unroll
            for (int m = 0; m < 4; ++m) {
                const int row = u.pm * 256 + ai * 128 + wr * 64 + m * 16 + fr;
                float sq = 0.f;
#pragma unroll
                for (int bj = 0; bj < 2; ++bj) {
                    const size_t off = (size_t)row * 1024 + u.pn * 256 + bj * 128 + wc * 32 + 8 * fq;
                    f32x4 r0, r1;
                    if (RESB) { const u32x4 w = *(const u32x4*)(resb + off); r0 = bf4_to_f32(w.x, w.y); r1 = bf4_to_f32(w.z, w.w); }
                    else { r0 = *(const f32x4*)(resf + off); r1 = *(const f32x4*)(resf + off + 4); }
                    const f32x4 v0 = r0 + acc[ai][bj][m][0] * coef, v1 = r1 + acc[ai][bj][m][1] * coef;
                    if (OUTF) { __builtin_nontemporal_store(v0, (f32x4*)(outf + off)); __builtin_nontemporal_store(v1, (f32x4*)(outf + off + 4)); }
                    if (HASB) *(u32x4*)(outb + off) = pack8(v0, v1);
                    sq += sq4(v0) + sq4(v1);
                }
                if (HASSS) { sq = red_fq(sq); if (fq == 0) ss[(size_t)row * 16 + u.pn * 4 + wc] = sq; }
            }
    }
};

template <int NP> struct EpiRowScale {
    static constexpr bool PERM = true, AFTER_DRAIN = false;
    bf16_t* O; int ldo; const float* ss; float invn; RsTable tab;
    __device__ __forceinline__ void operator()(const f32x4 (&acc)[2][2][4][2], const Unit& u, int wr, int wc, int fr, int fq) const {
#pragma unroll
        for (int ai = 0; ai < 2; ++ai)
#pragma unroll
            for (int m = 0; m < 4; ++m) {
                const int row = u.pm * 256 + ai * 128 + wr * 64 + m * 16 + fr;
                const float rs = NP < 0 ? rs_lookup(tab, u.pm, ai * 128 + wr * 64 + m * 16 + fr, row) : rsqrtf(ss_sum<(NP <= 0 ? 1 : NP)>(ss, row) * invn + EPS);
#pragma unroll
                for (int bj = 0; bj < 2; ++bj) {
                    const int col = u.pn * 256 + bj * 128 + wc * 32 + 8 * fq;
                    *(u32x4*)(O + (size_t)row * ldo + col) = pack8(acc[ai][bj][m][0] * rs, acc[ai][bj][m][1] * rs);
                }
            }
    }
};

template <int MODE> struct EpiGate {
    static constexpr bool PERM = true, AFTER_DRAIN = false;
    bf16_t* T; bf16_t* MIX; const bf16_t* raw; const float* bias; int goff;
    __device__ __forceinline__ void operator()(const f32x4 (&acc)[2][2][4][2], const Unit& u, int wr, int wc, int fr, int fq) const {
        f32x4 bg[2][2];
#pragma unroll
        for (int bj = 0; bj < 2; ++bj)
#pragma unroll
            for (int n = 0; n < 2; ++n) bg[bj][n] = *(const f32x4*)(bias + u.pn * 256 + bj * 128 + wc * 32 + 8 * fq + 4 * n);
#pragma unroll
        for (int ai = 0; ai < 2; ++ai)
#pragma unroll
            for (int m = 0; m < 4; ++m) {
                const int row = u.pm * 256 + ai * 128 + wr * 64 + m * 16 + fr;
#pragma unroll
                for (int bj = 0; bj < 2; ++bj) {
                    const int col = u.pn * 256 + bj * 128 + wc * 32 + 8 * fq;
                    const u32x4 gw = *(const u32x4*)(raw + (size_t)row * 4096 + goff + col);
                    f32x4 g0 = bf4_to_f32(gw.x, gw.y) + bg[bj][0], g1 = bf4_to_f32(gw.z, gw.w) + bg[bj][1];
#pragma unroll
                    for (int i = 0; i < 4; ++i) { g0[i] = sigm(g0[i]); g1[i] = sigm(g1[i]); }
                    f32x4 v0 = acc[ai][bj][m][0] * g0, v1 = acc[ai][bj][m][1] * g1;
                    bf16_t* tp = T + (size_t)row * 1024 + col;
                    if (MODE == 0) { *(u32x4*)tp = pack8(v0, v1); }
                    else { const u32x4 tw = *(const u32x4*)tp; v0 = v0 + bf4_to_f32(tw.x, tw.y); v1 = v1 + bf4_to_f32(tw.z, tw.w); *(u32x4*)(MIX + (size_t)row * 1024 + col) = pack8(v0, v1); }
                }
            }
    }
};
}

namespace attn {
#define ALAS __attribute__((address_space(3)))
typedef unsigned short bf16_t;
typedef short bf16x8 __attribute__((ext_vector_type(8)));
typedef short s16x4 __attribute__((ext_vector_type(4)));
typedef float f32x16 __attribute__((ext_vector_type(16)));
typedef float f32x4 __attribute__((ext_vector_type(4)));
typedef unsigned u32x4 __attribute__((ext_vector_type(4)));
typedef unsigned u32x2 __attribute__((ext_vector_type(2)));
typedef float f32x2_t __attribute__((ext_vector_type(2))); typedef __bf16 bf16x2_t __attribute__((ext_vector_type(2)));
__device__ __forceinline__ unsigned cvtpk(float lo, float hi) { f32x2_t v = {lo, hi}; bf16x2_t b = __builtin_convertvector(v, bf16x2_t); return __builtin_bit_cast(unsigned, b); }
__device__ __forceinline__ s16x4 vtr(const ALAS unsigned char* p) { return __builtin_bit_cast(s16x4, __builtin_amdgcn_ds_read_tr16_b64_v4i16((ALAS s16x4*)p)); }
constexpr float NEGBIG = -1e30f;
constexpr int VP = 144;


struct Tensors {
    const bf16_t* Q; int ldq, qoff;
    const bf16_t* KV; int ldkv, k1off, voff;
    const bf16_t* K2; int ldk2, k2off;
    bf16_t* O; int ldo, ooff;
    const float* logf;
    int hcol;
    const float* gq; const float* gk;
};

__device__ __forceinline__ float pl32max(float m) { auto rr = __builtin_amdgcn_permlane32_swap(__float_as_uint(m), __float_as_uint(m), false, false); return fmaxf(__uint_as_float(rr[0]), __uint_as_float(rr[1])); }
__device__ __forceinline__ float pl32sum(float m) { auto rr = __builtin_amdgcn_permlane32_swap(__float_as_uint(m), __float_as_uint(m), false, false); return __uint_as_float(rr[0]) + __uint_as_float(rr[1]); }

template <int DK, int NH, bool MASK, bool BIAS>
__device__ __forceinline__ void attn_qk(f32x16 (&x)[NH], const ALAS unsigned char* kbase, const ALAS float* tbp, const bf16x8 (&qf)[DK / 16], int r, int h, int kfirst, int qg) {
    constexpr int KP = DK * 2 + 16, NS = DK / 16;
#pragma unroll
    for (int hh = 0; hh < NH; ++hh) {
        if (BIAS) {
#pragma unroll
            for (int g = 0; g < 4; ++g) { const f32x4 a = *(const ALAS f32x4*)(tbp + 32 * hh + 4 * h + 8 * g);
                x[hh][4 * g] = a[0]; x[hh][4 * g + 1] = a[1]; x[hh][4 * g + 2] = a[2]; x[hh][4 * g + 3] = a[3]; }
        } else {
#pragma unroll
            for (int i = 0; i < 16; ++i) x[hh][i] = 0.f;
        }
    }
    { const ALAS unsigned char* kb = kbase + r * KP + h * 16;
      bf16x8 kf[2][NH];
#pragma unroll
      for (int hh = 0; hh < NH; ++hh) kf[0][hh] = *(const ALAS bf16x8*)(kb + hh * 32 * KP);
#pragma unroll
      for (int s = 0; s < NS; ++s) {
          if (s + 1 < NS) {
#pragma unroll
              for (int hh = 0; hh < NH; ++hh) kf[(s + 1) & 1][hh] = *(const ALAS bf16x8*)(kb + hh * 32 * KP + (s + 1) * 32);
          }
#pragma unroll
          for (int hh = 0; hh < NH; ++hh) x[hh] = __builtin_amdgcn_mfma_f32_32x32x16_bf16(kf[s & 1][hh], qf[s], x[hh], 0, 0, 0);
          __builtin_amdgcn_sched_barrier(0);
      } }
    if (MASK) {
#pragma unroll
        for (int hh = 0; hh < NH; ++hh)
#pragma unroll
            for (int i = 0; i < 16; ++i) { const int kv = kfirst + 32 * hh + 4 * h + (i & 3) + 8 * (i >> 2); if (kv > qg) x[hh][i] = NEGBIG; }
    }
}
template <int NH>
__device__ __forceinline__ void attn_pv(f32x16 (&x)[NH], const ALAS unsigned char* vbase, float& lrun, f32x16& o0, f32x16& o1, int h, int q4, int p4, int blk) {
    f32x2_t ps0 = {0.f, 0.f}, ps1 = {0.f, 0.f};
#pragma unroll
    for (int hh = 0; hh < NH; ++hh)
#pragma unroll
        for (int i = 0; i < 16; i += 4) {
            x[hh][i] = __builtin_amdgcn_exp2f(x[hh][i]); x[hh][i + 1] = __builtin_amdgcn_exp2f(x[hh][i + 1]);
            x[hh][i + 2] = __builtin_amdgcn_exp2f(x[hh][i + 2]); x[hh][i + 3] = __builtin_amdgcn_exp2f(x[hh][i + 3]);
            ps0 += (f32x2_t){x[hh][i], x[hh][i + 1]}; ps1 += (f32x2_t){x[hh][i + 2], x[hh][i + 3]}; }
    lrun += (ps0[0] + ps0[1]) + (ps1[0] + ps1[1]);
    const ALAS unsigned char* vb = vbase + (4 * h + q4) * VP + (16 * blk + 4 * p4) * 2;
    s16x4 vl[2][2];
#pragma unroll
    for (int dh = 0; dh < 2; ++dh) { vl[dh][0] = vtr(vb + dh * 64); vl[dh][1] = vtr(vb + 8 * VP + dh * 64); }
#pragma unroll
    for (int st = 0; st < 2 * NH; ++st) {
        const int hh = st >> 1, s2 = st & 1;
        u32x4 pw;
#pragma unroll
        for (int j = 0; j < 4; ++j) pw[j] = cvtpk(x[hh][8 * s2 + 2 * j], x[hh][8 * s2 + 2 * j + 1]);
        const bf16x8 pf = __builtin_bit_cast(bf16x8, pw);
        const bf16x8 vf0 = __builtin_shufflevector(vl[0][0], vl[0][1], 0, 1, 2, 3, 4, 5, 6, 7);
        const bf16x8 vf1 = __builtin_shufflevector(vl[1][0], vl[1][1], 0, 1, 2, 3, 4, 5, 6, 7);
        o0 = __builtin_amdgcn_mfma_f32_32x32x16_bf16(vf0, pf, o0, 0, 0, 0);
        o1 = __builtin_amdgcn_mfma_f32_32x32x16_bf16(vf1, pf, o1, 0, 0, 0);
        if (st + 1 < 2 * NH) {
#pragma unroll
            for (int dh = 0; dh < 2; ++dh) { vl[dh][0] = vtr(vb + (16 * (st + 1)) * VP + dh * 64); vl[dh][1] = vtr(vb + (16 * (st + 1) + 8) * VP + dh * 64); }
        }
        __builtin_amdgcn_sched_barrier(0);
    }
}

template <int DK, int NH, bool MASK, bool BIAS>
__device__ __forceinline__ void attn_step(const ALAS unsigned char* kbase, const ALAS unsigned char* vbase, const ALAS float* tbp, const bf16x8 (&qf)[DK / 16],
                                          float& mrun, float& lrun, f32x16& o0, f32x16& o1, int r, int h, int q4, int p4, int blk, int kfirst, int qg) {
    f32x16 x[NH]; attn_qk<DK, NH, MASK, BIAS>(x, kbase, tbp, qf, r, h, kfirst, qg); attn_pv<NH>(x, vbase, lrun, o0, o1, h, q4, p4, blk);
}

constexpr int A2_KS = 0, A2_VS = 2 * 128 * 208, A2_CUM = A2_VS + 2 * 128 * VP, A2_TB = A2_CUM + 2080 * 4, A2_SC = A2_TB + 2112 * 4, A2_MK = A2_SC + 64, A2_MV = A2_MK + 32 * 208, ATTN2_LDS = A2_MV + 32 * VP;

template <int DK, bool DECAY>
__device__ __forceinline__ void attn_bh(ALAS unsigned char* lds, const Tensors& T, int b) {
    constexpr int KP = DK * 2 + 16, NS = DK / 16;
    const int tid = threadIdx.x, lane = tid & 63, r = lane & 31, h = lane >> 5;
    const int w = __builtin_amdgcn_readfirstlane(tid >> 6);
    ALAS float* cum = (ALAS float*)(lds + A2_CUM);
    ALAS float* tb = (ALAS float*)(lds + A2_TB);
    ALAS float* sc = (ALAS float*)(lds + A2_SC);
    const size_t rowbase = (size_t)b * SEQ;
    if (DECAY) {
        float v[4];
#pragma unroll
        for (int i = 0; i < 4; ++i) v[i] = T.logf[(rowbase + 4 * tid + i) * 8 + T.hcol];
        v[1] += v[0]; v[2] += v[1]; v[3] += v[2];
        float s = v[3];
#pragma unroll
        for (int o = 1; o < 64; o <<= 1) { const float n = __shfl_up(s, o); if (lane >= o) s += n; }
        if (lane == 63) sc[w] = s;
        __syncthreads();
        float base = s - v[3];
        for (int i = 0; i < w; ++i) base += sc[i];
#pragma unroll
        for (int i = 0; i < 4; ++i) cum[NMETA + 4 * tid + i] = base + v[i];
        if (tid < NMETA) { float a = 0.f; for (int j = tid + 1; j < NMETA; ++j) a += T.logf[((size_t)MROWS + j) * 8 + T.hcol]; cum[tid] = -a; }
        __syncthreads();
    }
    float TSKIP = 3.0e38f;
    if (DECAY) { float a = 0.f, c = 0.f; for (int i = 0; i < 64; ++i) { a = fmaxf(a, fabsf(T.gq[i])); c = fmaxf(c, fabsf(T.gk[i])); }
        const float QB = 8.f * a * c * L2E * 1.01f; TSKIP = (37.f + 2.f * QB) * 0.6931471805599453f; }
    const int q4 = (lane & 15) >> 2, p4 = lane & 3, blk = (lane >> 4) & 1;
    const int vr0 = tid >> 3, vc = tid & 7, k2r = tid >> 2, k2c = tid & 3;
    const unsigned kvo = (unsigned)(vr0 * T.ldkv + 8 * vc) * 2u, k2o = (unsigned)(k2r * T.ldk2 + 8 * k2c) * 2u;
    const char* kvb = (const char*)T.KV; const char* k2b = (const char*)T.K2;
    for (int qb = 7; qb >= 0; --qb) {
        const int q0 = qb * 256, NST = 2 * qb + 2;
        int st_min = 0; bool skip_meta = false;
        if (DECAY) { const float cq0 = cum[NMETA + q0]; while (st_min < NST - 2 && cum[NMETA + 128 * st_min + 127] - cq0 >= TSKIP) ++st_min; skip_meta = (-cq0 >= TSKIP); }
        unsigned kvo_ = kvo, k2o_ = k2o; int rq_ = r; asm volatile("" : "+v"(kvo_), "+v"(k2o_), "+v"(rq_));
        { const float cref = DECAY ? cum[NMETA + q0 + 128] : 0.f;
          for (int idx = tid; idx < 32 + 128 * NST; idx += 512) { float val;
              if (idx < 32) val = (idx < NMETA) ? (DECAY ? (cref - cum[idx]) * L2E : 0.f) : NEGBIG;
              else val = DECAY ? (cref - cum[NMETA + idx - 32]) * L2E : 0.f;
              tb[idx] = val; } }
        bf16x8 qf[NS];
        { const bf16_t* qp = T.Q + (rowbase + q0 + 32 * w + rq_) * T.ldq + T.qoff + 8 * h;
#pragma unroll
          for (int s = 0; s < NS; ++s) qf[s] = *(const bf16x8*)(qp + 16 * s); }
        u32x4 kreg[2], k2reg = (u32x4){0u, 0u, 0u, 0u}, vreg[2];
#define AT_KVB(row_, off_) (kvb + ((size_t)(row_) * T.ldkv + (off_)) * 2)
#define AT_GLOAD_K(st_) do { _Pragma("unroll") for (int i_ = 0; i_ < 2; ++i_) kreg[i_] = *(const u32x4*)(AT_KVB(rowbase + 128 * (st_) + 64 * i_, T.k1off) + kvo_); \
            if (DK == 96) k2reg = *(const u32x4*)(k2b + ((size_t)(rowbase + 128 * (st_)) * T.ldk2 + T.k2off) * 2 + k2o_); } while (0)
#define AT_GLOAD_V(st_) do { _Pragma("unroll") for (int i_ = 0; i_ < 2; ++i_) vreg[i_] = *(const u32x4*)(AT_KVB(rowbase + 128 * (st_) + 64 * i_, T.voff) + kvo_); } while (0)
#define AT_LSTORE_K(buf_) do { _Pragma("unroll") for (int i_ = 0; i_ < 2; ++i_) *(ALAS u32x4*)(lds + A2_KS + (buf_) * 128 * KP + (vr0 + 64 * i_) * KP + vc * 16) = kreg[i_]; \
            if (DK == 96) *(ALAS u32x4*)(lds + A2_KS + (buf_) * 128 * KP + k2r * KP + 128 + k2c * 16) = k2reg; } while (0)
#define AT_LSTORE_V(buf_) do { _Pragma("unroll") for (int i_ = 0; i_ < 2; ++i_) *(ALAS u32x4*)(lds + A2_VS + (buf_) * 128 * VP + (vr0 + 64 * i_) * VP + vc * 16) = vreg[i_]; } while (0)
        { const u32x4 z = (u32x4){0u, 0u, 0u, 0u};
          if (tid < 256) { u32x4 kv = z, vv = z; if (vr0 < NMETA) { kv = *(const u32x4*)(AT_KVB((size_t)MROWS, T.k1off) + kvo_); vv = *(const u32x4*)(AT_KVB((size_t)MROWS, T.voff) + kvo_); }
              *(ALAS u32x4*)(lds + A2_MK + vr0 * KP + vc * 16) = kv; *(ALAS u32x4*)(lds + A2_MV + vr0 * VP + vc * 16) = vv; }
          if (DK == 96 && tid < 128) { u32x4 kv = z; if (k2r < NMETA) kv = *(const u32x4*)(k2b + ((size_t)MROWS * T.ldk2 + T.k2off) * 2 + k2o_);
              *(ALAS u32x4*)(lds + A2_MK + k2r * KP + 128 + k2c * 16) = kv; } }
        AT_GLOAD_K(st_min); AT_GLOAD_V(st_min);
        __syncthreads();
        float mrun = NEGBIG, lrun = 0.f;
        f32x16 o0, o1;
#pragma unroll
        for (int i = 0; i < 16; ++i) { o0[i] = 0.f; o1[i] = 0.f; }
        const int qg = q0 + 32 * w + r;
        if (!skip_meta) attn_step<DK, 1, false, true>(lds + A2_MK, lds + A2_MV, tb, qf, mrun, lrun, o0, o1, r, h, q4, p4, blk, 0, qg);
        if (st_min & 1) { AT_LSTORE_K(0); AT_LSTORE_V(0); } else { AT_LSTORE_K(1); AT_LSTORE_V(1); }
        if (st_min + 1 < NST) { AT_GLOAD_K(st_min + 1); AT_GLOAD_V(st_min + 1); }
        __syncthreads();
        for (int st = st_min; st < NST; ++st) {
            const int buf = (st + 1) & 1;
            const bool more = st + 1 < NST, more2 = st + 2 < NST;
            const int kt0 = 128 * st;
            if (more) AT_LSTORE_K(st & 1);
            if (more2) AT_GLOAD_K(st + 2);
            {
                const ALAS unsigned char* kb = lds + A2_KS + buf * 128 * KP; const ALAS unsigned char* vb = lds + A2_VS + buf * 128 * VP;
                const int wq0 = q0 + 32 * w;
                const bool act0 = kt0 <= wq0 + 31, act1 = kt0 + 64 <= wq0 + 31;
                f32x16 xa[2], xb[2];
                if (act0) { if (kt0 + 63 > wq0) attn_qk<DK, 2, true, DECAY>(xa, kb, tb + 32 + kt0, qf, r, h, kt0, qg); else attn_qk<DK, 2, false, DECAY>(xa, kb, tb + 32 + kt0, qf, r, h, kt0, qg); }
                if (act1) { if (kt0 + 127 > wq0) attn_qk<DK, 2, true, DECAY>(xb, kb + 64 * KP, tb + 96 + kt0, qf, r, h, kt0 + 64, qg); else attn_qk<DK, 2, false, DECAY>(xb, kb + 64 * KP, tb + 96 + kt0, qf, r, h, kt0 + 64, qg); }
                __builtin_amdgcn_sched_barrier(0);
                if (more) AT_LSTORE_V(st & 1); if (more2) AT_GLOAD_V(st + 2);
                if (act0) attn_pv<2>(xa, vb, lrun, o0, o1, h, q4, p4, blk);
                if (act1) attn_pv<2>(xb, vb + 64 * VP, lrun, o0, o1, h, q4, p4, blk);
            }
            __syncthreads();
        }
        lrun = pl32sum(lrun);
        const float inv = 1.f / lrun;
        bf16_t* op = T.O + (rowbase + q0 + 32 * w + rq_) * T.ldo + T.ooff + 4 * h;
#pragma unroll
        for (int g = 0; g < 4; ++g) {
            u32x2 a, c;
            a.x = cvtpk(o0[4 * g] * inv, o0[4 * g + 1] * inv); a.y = cvtpk(o0[4 * g + 2] * inv, o0[4 * g + 3] * inv);
            c.x = cvtpk(o1[4 * g] * inv, o1[4 * g + 1] * inv); c.y = cvtpk(o1[4 * g + 2] * inv, o1[4 * g + 3] * inv);
            *(u32x2*)(op + 8 * g) = a; *(u32x2*)(op + 32 + 8 * g) = c;
        }
    }
    __syncthreads();
}
#undef AT_KVB
#undef AT_GLOAD_K
#undef AT_GLOAD_V
#undef AT_LSTORE_K
#undef AT_LSTORE_V
}

#define LAS __attribute__((address_space(3)))
typedef unsigned short bf16;
typedef unsigned v4u __attribute__((ext_vector_type(4)));
typedef unsigned v2u __attribute__((ext_vector_type(2)));
typedef float f32x4 __attribute__((ext_vector_type(4)));
constexpr int NWAVES = 8;
constexpr int LDS_BYTES = 147456;
constexpr int RING_BYTES = 131072;
static_assert(attn::ATTN2_LDS <= RING_BYTES, "attention LDS");
#ifndef MK_N_LAUNCHES
#define MK_N_LAUNCHES 1
#endif
#ifndef STOP_PHASE
#define STOP_PHASE 12
#endif
constexpr int NPHASE = STOP_PHASE;


constexpr size_t MiB = 1u << 20;
constexpr size_t WS_SS0 = 0, WS_SSCQ = MiB / 2, WS_SSCKV = MiB, WS_BAR = 2 * MiB, WS_ROPE = 3 * MiB;
constexpr size_t WS_WGU1 = 4 * MiB, WS_WD1 = 15 * MiB, WS_WGU2 = 21 * MiB, WS_WD2 = 32 * MiB, WS_WIN = 38 * MiB, WS_WUQ = 46 * MiB, WS_WUKV = 47 * MiB,
                 WS_WBF = 48 * MiB, WS_WBM = 49 * MiB, WS_WOUT = 50 * MiB;
constexpr size_t WS_AB = 52 * MiB;
constexpr size_t WS_AF = 52 * MiB, WS_AM = 116 * MiB;
constexpr size_t WS_HMID = 181 * MiB;
constexpr size_t WS_RAW = 181 * MiB;
constexpr size_t WS_QRAW = 695 * MiB, WS_KVRAW = 791 * MiB, WS_KR = 920 * MiB, WS_LOGF = 953 * MiB, WS_SS1P = 956 * MiB, WS_SS2P = 961 * MiB, WS_END = 966 * MiB;
constexpr size_t WS_T = 695 * MiB, WS_MIX = 823 * MiB;
static_assert(WS_AB + (size_t)MROWS1 * 1024 * 2 <= WS_HMID && WS_HMID + (size_t)MROWS1 * 2816 * 2 <= WS_QRAW && WS_RAW + (size_t)MROWS1 * 4096 * 2 <= WS_QRAW &&
              WS_QRAW + (size_t)MROWS * 768 * 2 <= WS_KVRAW && WS_KVRAW + (size_t)MROWS1 * 1024 * 2 <= WS_KR && WS_KR + (size_t)MROWS1 * 256 * 2 <= WS_LOGF &&
              WS_LOGF + (size_t)MROWS1 * 32 <= WS_SS1P && WS_SS1P + (size_t)MROWS1 * 64 <= WS_SS2P && WS_SS2P + (size_t)MROWS1 * 64 <= WS_END &&
              WS_T + (size_t)MROWS * 1024 * 2 <= WS_MIX && WS_MIX + (size_t)MROWS * 1024 * 2 <= WS_LOGF && WS_AM + (size_t)MROWS * 512 * 2 <= WS_HMID, "d_ws map");

#define XB_TMO      128
#define XB_XCNT(j)  (256  + 64 * (j))
#define XB_XSUB(j)  (1280 + 64 * (j))
#define XB_XGEN(j)  (2304 + 64 * (j))
#define XB_TOP      3328
#define XB_TOPGEN   3392
#define XCD_BAR_WORDS 3456
#define XB_SPIN_CAP (1u << 18)

__device__ __forceinline__ unsigned xb_ld(unsigned* p)              { return __hip_atomic_load(p, __ATOMIC_RELAXED, __HIP_MEMORY_SCOPE_AGENT); }
__device__ __forceinline__ unsigned xb_add(unsigned* p, unsigned v) { return __hip_atomic_fetch_add(p, v, __ATOMIC_RELAXED, __HIP_MEMORY_SCOPE_AGENT); }
__device__ __forceinline__ unsigned xb_xcc_id() { return (unsigned)__builtin_amdgcn_s_getreg((3 << 11) | 20) & 0xFu; }
#define XB_SPIN(cond, bar) do { unsigned _sp = 0; while (cond) { __builtin_amdgcn_s_sleep(1); \
    if ((++_sp & 255u) == 0u) { if (xb_ld(&(bar)[XB_TMO])) break; if (_sp > XB_SPIN_CAP) { atomicAdd(&(bar)[XB_TMO], 1u); break; } } } } while (0)

struct XcdBarrier {
    unsigned* bar; unsigned x;
    volatile LAS unsigned* st;
};

__device__ __forceinline__ XcdBarrier xcd_barrier_post(unsigned* bar, volatile LAS unsigned* st) {
    XcdBarrier b; b.bar = bar; b.x = xb_xcc_id(); b.st = st;
    if (threadIdx.x == 0) (void)xb_add(&bar[XB_XCNT(b.x)], 1u);
    return b;
}
__device__ __forceinline__ void xcd_barrier_complete(unsigned* bar, unsigned x, unsigned& nloc, unsigned& nx) {
    const unsigned G = gridDim.x * gridDim.y * gridDim.z;
    unsigned sum, cnt, mine, sp = 0u;
    for (;;) {
        sum = 0u; cnt = 0u; mine = 0u;
#pragma unroll
        for (unsigned j = 0; j < 16; ++j) { const unsigned c = xb_ld(&bar[XB_XCNT(j)]); sum += c; cnt += (c > 0u) ? 1u : 0u; mine = (j == x) ? c : mine; }
        if (sum == G) break;
        __builtin_amdgcn_s_sleep(1);
        if ((++sp & 255u) == 0u) { if (xb_ld(&bar[XB_TMO])) break; if (sp > XB_SPIN_CAP) { atomicAdd(&bar[XB_TMO], 1u); break; } }
    }
    nloc = mine > 0u ? mine : 1u; nx = cnt > 0u ? cnt : 1u;
}

__device__ __forceinline__ void xcd_barrier(const XcdBarrier& b) {
    asm volatile("s_waitcnt vmcnt(0)" ::: "memory");
    __syncthreads();
    if (threadIdx.x == 0) {
        unsigned* bar = b.bar;
        __builtin_amdgcn_s_waitcnt(0);
        unsigned nloc = b.st[0], nx = b.st[1];
        if (nloc == 0u) { xcd_barrier_complete(bar, b.x, nloc, nx); b.st[0] = nloc; b.st[1] = nx; }
        const unsigned old = xb_add(&bar[XB_XSUB(b.x)], 1u);
        const unsigned gen = old / nloc;
        if (old + 1u == (gen + 1u) * nloc) {
            __builtin_amdgcn_fence(__ATOMIC_RELEASE, "agent");
            asm volatile("s_waitcnt vmcnt(0)" ::: "memory");
            const unsigned og = xb_add(&bar[XB_TOP], 1u);
            const unsigned tg = og / nx;
            if (og + 1u == (tg + 1u) * nx) xb_add(&bar[XB_TOPGEN], 1u);
            else XB_SPIN(xb_ld(&bar[XB_TOPGEN]) == tg, bar);
            __builtin_amdgcn_fence(__ATOMIC_ACQUIRE, "agent");
            xb_add(&bar[XB_XGEN(b.x)], 1u);
            asm volatile("s_waitcnt vmcnt(0)" ::: "memory");
        } else {
            XB_SPIN(xb_ld(&bar[XB_XGEN(b.x)]) == gen, bar);
            __builtin_amdgcn_fence(__ATOMIC_ACQUIRE, "agent");
            asm volatile("s_waitcnt vmcnt(0)" ::: "memory");
        }
    }
    __syncthreads();
}

struct Args { const float* in[23]; float* out; unsigned char* ws; int ph_lo, ph_hi; };
static_assert(sizeof(Args) == 26 * 8, "Args has no padding");

__device__ __forceinline__ unsigned f2bf(float f) { unsigned u = __builtin_bit_cast(unsigned, f); return (u + 0x7fffu + ((u >> 16) & 1u)) >> 16; }
__device__ __forceinline__ unsigned pk2(float lo, float hi) { return f2bf(lo) | (f2bf(hi) << 16); }
__device__ __forceinline__ float bflo(unsigned w) { return __uint_as_float(w << 16); }
__device__ __forceinline__ float bfhi(unsigned w) { return __uint_as_float(w & 0xffff0000u); }
__device__ __forceinline__ float wave_sum(float v) {
#pragma unroll
    for (int o = 1; o < 64; o <<= 1) v += __shfl_xor(v, o);
    return v;
}
__device__ __forceinline__ void tr_item(const float* W, int ldw, int scol0, int nvalid, const float* gain, bf16* WT, int K, int drow0, int k0, LAS float* scr, int lane) {
    const int ng = lane & 7, kr = lane >> 3;
#pragma unroll
    for (int i = 0; i < 8; ++i) { const int kk = 8 * i + kr; f32x4 v = (f32x4){0.f, 0.f, 0.f, 0.f};
        if (4 * ng < nvalid) { v = *(const f32x4*)(W + (size_t)(k0 + kk) * ldw + scol0 + 4 * ng); if (gain) v = v * gain[k0 + kk]; }
        scr[kk * 33 + 4 * ng] = v[0]; scr[kk * 33 + 4 * ng + 1] = v[1]; scr[kk * 33 + 4 * ng + 2] = v[2]; scr[kk * 33 + 4 * ng + 3] = v[3]; }
    asm volatile("s_waitcnt lgkmcnt(0)" ::: "memory");
    const int c = lane & 7;
#pragma unroll
    for (int j = 0; j < 4; ++j) { const int n = (lane >> 3) + 8 * j; const LAS float* s = scr + (8 * c) * 33 + n;
        v4u o; o.x = pk2(s[0 * 33], s[1 * 33]); o.y = pk2(s[2 * 33], s[3 * 33]); o.z = pk2(s[4 * 33], s[5 * 33]); o.w = pk2(s[6 * 33], s[7 * 33]);
        *(v4u*)(WT + (size_t)(drow0 + n) * K + k0 + 8 * c) = o; }
    asm volatile("s_waitcnt lgkmcnt(0)" ::: "memory");
}
typedef short sk_bf16x8 __attribute__((ext_vector_type(8)));
template <int NB> __device__ __forceinline__ void skinny16(const bf16* A, int lda, const bf16* Bt, int ldb, int K, const int (&brow)[NB], f32x4 (&acc)[NB], int lane) {
    const bf16* ap = A + (size_t)(lane & 15) * lda + 8 * (lane >> 4);
    const bf16* bp[NB];
#pragma unroll
    for (int b = 0; b < NB; ++b) { bp[b] = Bt + (size_t)(brow[b] + (lane & 15)) * ldb + 8 * (lane >> 4); acc[b] = (f32x4){0.f, 0.f, 0.f, 0.f}; }
#pragma unroll 4
    for (int k0 = 0; k0 < K; k0 += 32) {
        const sk_bf16x8 a = *(const sk_bf16x8*)(ap + k0);
#pragma unroll
        for (int b = 0; b < NB; ++b) { const sk_bf16x8 bb = *(const sk_bf16x8*)(bp[b] + k0); acc[b] = __builtin_amdgcn_mfma_f32_16x16x32_bf16(a, bb, acc[b], 0, 0, 0); }
    }
}
template <int NB> __device__ __forceinline__ void skinny16_wg(LAS unsigned char* lds, const bf16* A, int lda, const bf16* Bt, int ldb, int K, const int (&brow)[NB], f32x4 (&acc)[NB], int lane, int wave) {
    const int kper = K / 8;
    skinny16<NB>(A + wave * kper, lda, Bt + wave * kper, ldb, kper, brow, acc, lane);
    LAS f32x4* red = (LAS f32x4*)lds;
#pragma unroll
    for (int b = 0; b < NB; ++b) red[(wave * NB + b) * 64 + lane] = acc[b];
    __syncthreads();
    if (wave == 0) {
#pragma unroll
        for (int w = 1; w < 8; ++w)
#pragma unroll
            for (int b = 0; b < NB; ++b) acc[b] = acc[b] + red[(w * NB + b) * 64 + lane];
    }
    __syncthreads();
}
__device__ __forceinline__ float ss16(const float* p, int row) { float s = 0.f;
#pragma unroll
    for (int i = 0; i < 4; ++i) { const f32x4 v = *(const f32x4*)(p + (size_t)row * 16 + 4 * i); s += (v[0] + v[1]) + (v[2] + v[3]); }
    return s; }

__global__ void __launch_bounds__(NWAVES * 64, 2) fwd_kernel(Args args) {
    extern __shared__ __attribute__((aligned(16))) unsigned char lds_raw[];
    LAS unsigned char* lds = (LAS unsigned char*)lds_raw;
    const int tid = threadIdx.x, lane = tid & 63, wave = __builtin_amdgcn_readfirstlane(tid >> 6);
    const int G = gridDim.x, bx = blockIdx.x;
    volatile LAS unsigned* barst = (volatile LAS unsigned*)(lds + RING_BYTES + 64);
    if (tid < 2) barst[tid] = 0u;
    __syncthreads();
    XcdBarrier xbar; xbar.bar = (unsigned*)(args.ws + WS_BAR); xbar.x = 0; xbar.st = barst;
    unsigned char* ws = args.ws;
    const float* x = args.in[0]; const float* meta = args.in[1];
    float* out = args.out;
    float *SS0 = (float*)(ws + WS_SS0), *SS1 = (float*)(ws + WS_SS1P), *SS2 = (float*)(ws + WS_SS2P), *SSCQ = (float*)(ws + WS_SSCQ), *SSCKV = (float*)(ws + WS_SSCKV), *ROPE = (float*)(ws + WS_ROPE);
    bf16 *WGU1 = (bf16*)(ws + WS_WGU1), *WD1 = (bf16*)(ws + WS_WD1), *WGU2 = (bf16*)(ws + WS_WGU2), *WD2 = (bf16*)(ws + WS_WD2), *WIN = (bf16*)(ws + WS_WIN), *WUQ = (bf16*)(ws + WS_WUQ),
         *WUKV = (bf16*)(ws + WS_WUKV), *WBF = (bf16*)(ws + WS_WBF), *WBM = (bf16*)(ws + WS_WBM), *WOUT = (bf16*)(ws + WS_WOUT);
    bf16 *AB = (bf16*)(ws + WS_AB), *AF = (bf16*)out, *AM = (bf16*)out + (size_t)MROWS * 512,
         *HMID = (bf16*)(ws + WS_HMID), *RAW = (bf16*)(ws + WS_RAW), *QRAW = (bf16*)(ws + WS_QRAW);
    bf16 *KVRAW = (bf16*)(ws + WS_KVRAW), *KR = (bf16*)(ws + WS_KR), *MIX = (bf16*)(ws + WS_MIX), *TT = (bf16*)(ws + WS_T);
    float *LOGF = (float*)(ws + WS_LOGF);
    const int lo = args.ph_lo, hi = args.ph_hi;
#ifndef SKIP_MASK
#define SKIP_MASK 0
#endif
#define IN(k) (lo <= (k) && (k) < hi)
#define RUN(k) (IN(k) && !((SKIP_MASK >> (k)) & 1))
#ifndef REPEAT_MASK
#define REPEAT_MASK 0
#endif
#define NREP(k) (((REPEAT_MASK >> (k)) & 1) ? 2 : 1)
#define SEAM(k) do { if (IN(k) && IN((k) + 1)) { if ((k) == 0) { cg::this_grid().sync(); xbar = xcd_barrier_post((unsigned*)(args.ws + WS_BAR), barst); } else { xcd_barrier(xbar); } } } while (0)
    const int gw = bx * NWAVES + wave, NGW = G * NWAVES;
#define RS_FILL(S_, SSP_) do { LAS int* pml_ = (LAS int*)(lds + RING_BYTES + 512); LAS float* rsl_ = (LAS float*)(lds + RING_BYTES + 1024); \
        if (tid == 0) { int cnt_ = 0; pg8::Unit u_; for (int i_ = 0; (S_).next(i_, u_); ++i_) { bool seen_ = false; for (int k_ = 0; k_ < cnt_; ++k_) seen_ = seen_ || (pml_[k_] == u_.pm); \
            if (!seen_ && cnt_ < 8) pml_[cnt_++] = u_.pm; } pml_[8] = cnt_; } \
        __syncthreads(); \
        { const int cnt_ = pml_[8]; for (int idx_ = tid; idx_ < cnt_ * 256; idx_ += NWAVES * 64) { const int row_ = pml_[idx_ >> 8] * 256 + (idx_ & 255); rsl_[idx_] = rsqrtf(ss16((SSP_), row_) * (1.f / 1024.f) + EPS); } } \
        __syncthreads(); } while (0)
#define RS_TABLE(SSP_) epi::RsTable{(const LAS float*)(lds + RING_BYTES + 1024), (const LAS int*)(lds + RING_BYTES + 512), ((const LAS int*)(lds + RING_BYTES + 512))[8], (SSP_)}
    constexpr int C_FQ = 0, C_FK = 512, C_FV = 1024, C_FL = 1536, C_CQ = 1544, C_CKV = 1800, C_KR = 1928, C_GATE = 1960;

    if (RUN(0)) {
        if (bx == 0) for (int i = tid; i < XCD_BAR_WORDS; i += NWAVES * 64) ((unsigned*)(ws + WS_BAR))[i] = 0u;
        for (int i = bx * 512 + tid; i < 2064 * 16; i += G * 512) { const int pos = i >> 4, fi = i & 15;
            const float invf = __builtin_amdgcn_exp2f(-(float)fi * 0.8304820237218406f);
            const double rev = (double)((float)pos * invf) * 0.15915494309189535; const float fr = (float)(rev - floor(rev));
            ROPE[2 * i] = __builtin_amdgcn_cosf(fr); ROPE[2 * i + 1] = __builtin_amdgcn_sinf(fr); }
        LAS float* scr = (LAS float*)(lds + wave * 16384);
        constexpr int I_GU = 176 * 16, I_D = 32 * 44, I_WIN = 128 * 16, I_UQ = 24 * 4, I_UKV = 32 * 4, I_B = 32 * 8, I_OUT = 32 * 16;
        constexpr int NITEMS = 2 * I_GU + 2 * I_D + I_WIN + I_UQ + I_UKV + 2 * I_B + I_OUT;
        for (int it = gw; it < NITEMS; it += NGW) {
            int r = it;
            if (r < 2 * I_GU) { const int l = r / I_GU; r -= l * I_GU; const int rb = r / 16, kb = r % 16; const int pn = rb >> 3, bj = (rb >> 2) & 1, q = rb & 3;
                tr_item(args.in[l ? 21 : 3], 5632, bj * 2816 + pn * 128 + q * 32, 32, args.in[l ? 20 : 2], l ? WGU2 : WGU1, 1024, rb * 32, kb * 64, scr, lane); continue; } r -= 2 * I_GU;
            if (r < 2 * I_D) { const int l = r / I_D; r -= l * I_D; const int rb = r / 44, kb = r % 44;
                tr_item(args.in[l ? 22 : 4], 1024, rb * 32, 32, nullptr, l ? WD2 : WD1, 2816, rb * 32, kb * 64, scr, lane); continue; } r -= 2 * I_D;
            if (r < I_WIN) { const int rb = r / 16, kb = r % 16; const int nv = (rb * 32 + 32 <= 4008) ? 32 : ((rb * 32 < 4008) ? 4008 - rb * 32 : 0);
                tr_item(args.in[6], 4008, rb * 32, nv, args.in[5], WIN, 1024, rb * 32, kb * 64, scr, lane); continue; } r -= I_WIN;
            if (r < I_UQ) { const int rb = r / 4, kb = r % 4; tr_item(args.in[12], 768, rb * 32, 32, args.in[11], WUQ, 256, rb * 32, kb * 64, scr, lane); continue; } r -= I_UQ;
            if (r < I_UKV) { const int rb = r / 4, kb = r % 4;
                tr_item(args.in[14], 1024, rb * 32, kb < 2 ? 32 : 0, args.in[13], WUKV, 256, rb * 32, kb * 64, scr, lane); continue; } r -= I_UKV;
            if (r < 2 * I_B) { const int l = r / I_B; r -= l * I_B; const int rb = r / 8, kb = r % 8;
                tr_item(args.in[l ? 18 : 17], 1024, rb * 32, 32, nullptr, l ? WBM : WBF, 512, rb * 32, kb * 64, scr, lane); continue; } r -= 2 * I_B;
            { const int rb = r / 16, kb = r % 16; tr_item(args.in[19], 1024, rb * 32, 32, nullptr, WOUT, 1024, rb * 32, kb * 64, scr, lane); }
        }
        for (int m0 = 2 * gw; m0 < MROWS + NMETA; m0 += 2 * NGW) {
            f32x4 v[2][4];
#pragma unroll
            for (int q = 0; q < 2; ++q) { const int m = m0 + q; const float* src = (m < MROWS) ? x + (size_t)m * 1024 : meta + (size_t)(m - MROWS) * 1024;
#pragma unroll
                for (int j = 0; j < 4; ++j) v[q][j] = *(const f32x4*)(src + 8 * lane + 512 * (j >> 1) + 4 * (j & 1)); }
#pragma unroll
            for (int q = 0; q < 2; ++q) { float s = 0.f;
#pragma unroll
                for (int j = 0; j < 4; ++j) s += (v[q][j][0] * v[q][j][0] + v[q][j][1] * v[q][j][1]) + (v[q][j][2] * v[q][j][2] + v[q][j][3] * v[q][j][3]);
                s = wave_sum(s); if (lane == 0) SS0[m0 + q] = s;
                const float rs0 = rsqrtf(s * (1.f / 1024.f) + EPS);
#pragma unroll
                for (int j = 0; j < 2; ++j) { const f32x4 t0 = v[q][2 * j] * rs0, t1 = v[q][2 * j + 1] * rs0; v4u o; o.x = pk2(t0[0], t0[1]); o.y = pk2(t0[2], t0[3]); o.z = pk2(t1[0], t1[1]); o.w = pk2(t1[2], t1[3]);
                    *(v4u*)(AB + (size_t)(m0 + q) * 1024 + 8 * lane + 512 * j) = o; }
            }
        }
    }
    SEAM(0);
    if (RUN(1)) {
        if (bx < 176) {
            const int pn = bx >> 3, jb = bx & 7; const int brow[2] = {256 * pn + 16 * jb, 256 * pn + 128 + 16 * jb}; f32x4 acc[2];
            skinny16_wg<2>(lds, AB + (size_t)MROWS * 1024, 1024, WGU1, 1024, 1024, brow, acc, lane, wave);
            if (wave == 0)
#pragma unroll
            for (int j = 0; j < 4; ++j) { const int row = MROWS + 4 * (lane >> 4) + j;
                const float gg = acc[0][j], uu = acc[1][j]; const float hv = gg * epi::sigm(gg) * uu;
                HMID[(size_t)row * 2816 + 128 * pn + 16 * jb + (lane & 15)] = (bf16)f2bf(hv); }
        }
        pg8::Gemm g{AB, WGU1, MROWS, 5632, 1024, 1024}; pg8::StaticOrder S; S.init(MROWS, 5632, G, bx);
        epi::EpiSwiglu<0> E{HMID, 2816, SS0, {}}; pg8::gemm_phase<epi::EpiSwiglu<0>, pg8::StaticOrder, true, true>(lds, g, S, E); }
    SEAM(1);
    if (RUN(2)) {
        if (bx < 16) {
            const int brow[4] = {64 * bx, 64 * bx + 16, 64 * bx + 32, 64 * bx + 48}; f32x4 acc[4];
            skinny16_wg<4>(lds, HMID + (size_t)MROWS * 2816, 2816, WD1, 2816, 2816, brow, acc, lane, wave);
            if (wave == 0)
#pragma unroll
            for (int j = 0; j < 4; ++j) { const int r16 = 4 * (lane >> 4) + j; float sq = 0.f;
#pragma unroll
                for (int b = 0; b < 4; ++b) { const int col = 64 * bx + 16 * b + (lane & 15); const float v = meta[(size_t)r16 * 1024 + col] + 0.5f * acc[b][j];
                    AB[(size_t)(MROWS + r16) * 1024 + col] = (bf16)f2bf(v); sq += v * v; }
                sq += __shfl_xor(sq, 1); sq += __shfl_xor(sq, 2); sq += __shfl_xor(sq, 4); sq += __shfl_xor(sq, 8);
                if ((lane & 15) == 0) SS1[(size_t)(MROWS + r16) * 16 + bx] = sq; }
        }
        pg8::Gemm g{HMID, WD1, MROWS, 1024, 2816, 2816}; pg8::StaticOrder S; S.init(MROWS, 1024, G, bx);
        epi::EpiRes<true, false, false, true, true> E{x, nullptr, nullptr, AB, SS1}; pg8::gemm_phase<epi::EpiRes<true, false, false, true, true>, pg8::StaticOrder, true, true>(lds, g, S, E); }
    SEAM(2);
    if (RUN(3)) {
        if (bx < 91) {
            const int brow[1] = {512 + 16 * bx}; f32x4 acc[1];
            skinny16_wg<1>(lds, AB + (size_t)MROWS * 1024, 1024, WIN, 1024, 1024, brow, acc, lane, wave);
            if (wave == 0)
#pragma unroll
            for (int j = 0; j < 4; ++j) { const int row = MROWS + 4 * (lane >> 4) + j; const float rs = rsqrtf(ss16(SS1, row) * (1.f / 1024.f) + EPS);
                RAW[(size_t)row * 4096 + 512 + 16 * bx + (lane & 15)] = (bf16)f2bf(acc[0][j] * rs); }
        }
        pg8::Gemm g{AB, WIN, MROWS, 4096, 1024, 1024}; pg8::StaticOrder S; S.init(MROWS, 4096, G, bx);
        RS_FILL(S, SS1);
        epi::EpiRowScale<-1> E{RAW, 4096, SS1, 1.f / 1024.f, RS_TABLE(SS1)}; pg8::gemm_phase<epi::EpiRowScale<-1>, pg8::StaticOrder, true, true>(lds, g, S, E); }
    SEAM(3);
    if (RUN(4)) {
        const float* gfq = args.in[9]; const float* gfk = args.in[10]; const float* bfor = args.in[7];
        const int hd16 = lane >> 2, sub = lane & 3;
        for (int row0 = 2 * gw; row0 < MROWS + NMETA; row0 += 2 * NGW) {
            v4u a[2], b[2]; v2u c[2]; unsigned d[2]; unsigned short fl[2];
#pragma unroll
            for (int q = 0; q < 2; ++q) { const bf16* rp = RAW + (size_t)(row0 + q) * 4096; const bf16* p = rp + hd16 * 64 + sub * 16;
                a[q] = *(const v4u*)p; b[q] = *(const v4u*)(p + 8); c[q] = *(const v2u*)(rp + C_CQ + 4 * lane); d[q] = *(const unsigned*)(rp + C_CKV + 2 * lane); fl[q] = rp[C_FL + (lane & 7)]; }
#pragma unroll
            for (int q = 0; q < 2; ++q) { const int row = row0 + q; bf16* rp = RAW + (size_t)row * 4096; bf16* p = rp + hd16 * 64 + sub * 16;
              { float v[16];
                v[0] = bflo(a[q].x); v[1] = bfhi(a[q].x); v[2] = bflo(a[q].y); v[3] = bfhi(a[q].y); v[4] = bflo(a[q].z); v[5] = bfhi(a[q].z); v[6] = bflo(a[q].w); v[7] = bfhi(a[q].w);
                v[8] = bflo(b[q].x); v[9] = bfhi(b[q].x); v[10] = bflo(b[q].y); v[11] = bfhi(b[q].y); v[12] = bflo(b[q].z); v[13] = bfhi(b[q].z); v[14] = bflo(b[q].w); v[15] = bfhi(b[q].w);
                float s = 0.f;
#pragma unroll
                for (int i = 0; i < 16; ++i) s += v[i] * v[i];
                s += __shfl_xor(s, 1); s += __shfl_xor(s, 2);
                const float* gn = (hd16 < 8 ? gfq : gfk) + sub * 16;
                const float rr = rsqrtf(s * (1.f / 64.f) + EPS) * (hd16 < 8 ? 0.125f * L2E : 1.f);
#pragma unroll
                for (int i = 0; i < 16; ++i) v[i] = v[i] * rr * gn[i];
                v4u oa, ob; oa.x = pk2(v[0], v[1]); oa.y = pk2(v[2], v[3]); oa.z = pk2(v[4], v[5]); oa.w = pk2(v[6], v[7]);
                ob.x = pk2(v[8], v[9]); ob.y = pk2(v[10], v[11]); ob.z = pk2(v[12], v[13]); ob.w = pk2(v[14], v[15]);
                *(v4u*)p = oa; *(v4u*)(p + 8) = ob; }
              if (lane < 8) { const float z = __uint_as_float((unsigned)fl[q] << 16) + bfor[lane];
                LOGF[(size_t)row * 8 + lane] = fminf(z, 0.f) - log1pf(expf(-fabsf(z))); }
              { float s1 = bflo(c[q].x) * bflo(c[q].x) + bfhi(c[q].x) * bfhi(c[q].x) + bflo(c[q].y) * bflo(c[q].y) + bfhi(c[q].y) * bfhi(c[q].y);
                float s2 = bflo(d[q]) * bflo(d[q]) + bfhi(d[q]) * bfhi(d[q]);
                s1 = wave_sum(s1); s2 = wave_sum(s2);
                if (lane == 0) { SSCQ[row] = s1; SSCKV[row] = s2; } }
            }
        }
    }
    SEAM(4);
    if (RUN(5)) {
        if (gw < 64) {
            const int brow[1] = {16 * gw}; f32x4 acc[1];
            skinny16<1>(RAW + (size_t)MROWS * 4096 + C_CKV, 4096, WUKV, 256, 128, brow, acc, lane);
#pragma unroll
            for (int j = 0; j < 4; ++j) { const int row = MROWS + 4 * (lane >> 4) + j; const float rs = rsqrtf(SSCKV[row] * (1.f / 128.f) + EPS);
                KVRAW[(size_t)row * 1024 + 16 * gw + (lane & 15)] = (bf16)f2bf(acc[0][j] * rs); }
        }
        { pg8::Gemm g{RAW + C_CQ, WUQ, MROWS, 768, 256, 4096}; pg8::StaticOrder S; S.init(MROWS, 768, G, bx);
          epi::EpiRowScale<1> E{QRAW, 768, SSCQ, 1.f / 256.f, {}}; pg8::gemm_phase<epi::EpiRowScale<1>, pg8::StaticOrder, true, true>(lds, g, S, E); }
        { pg8::Gemm g{RAW + C_CKV, WUKV, MROWS, 1024, 256, 4096}; pg8::StaticOrder S; S.init(MROWS, 1024, G, bx);
          epi::EpiRowScale<1> E{KVRAW, 1024, SSCKV, 1.f / 128.f, {}}; pg8::gemm_phase<epi::EpiRowScale<1>, pg8::StaticOrder, true, true>(lds, g, S, E); }
    }
    SEAM(5);
    if (RUN(6)) {
        const float* gqn = args.in[15]; const float* gkn = args.in[16];
        const int hd = lane >> 3, sub = lane & 7;
        const float QS = 0.10206207261596577f * L2E;
        constexpr int NTOT = 2 * MROWS + NMETA;
        for (int m0 = gw; m0 < NTOT; m0 += 2 * NGW) {
            bool isq[2], val[2]; int row[2], pos[2]; v4u a[2]; unsigned b1[2], b2[2];
#pragma unroll
            for (int q = 0; q < 2; ++q) { const int m = m0 + q * NGW; val[q] = m < NTOT; const int mm = val[q] ? m : m0;
                isq[q] = mm < MROWS; row[q] = isq[q] ? mm : mm - MROWS; pos[q] = (row[q] < MROWS) ? NMETA + (row[q] & (SEQ - 1)) : row[q] - MROWS;
                if (isq[q]) { const bf16* p = QRAW + (size_t)row[q] * 768 + hd * 96; a[q] = *(const v4u*)(p + 8 * sub); b1[q] = *(const unsigned*)(p + 64 + 2 * sub); b2[q] = *(const unsigned*)(p + 80 + 2 * sub); }
                else { const bf16* p = KVRAW + (size_t)row[q] * 1024 + hd * 128; const bf16* kr = RAW + (size_t)row[q] * 4096 + C_KR;
                    a[q] = *(const v4u*)(p + 8 * sub); b1[q] = *(const unsigned*)(kr + 2 * sub); b2[q] = *(const unsigned*)(kr + 16 + 2 * sub); } }
#pragma unroll
            for (int q = 0; q < 2; ++q) {
                float nv[8], x1[2], x2[2];
                nv[0] = bflo(a[q].x); nv[1] = bfhi(a[q].x); nv[2] = bflo(a[q].y); nv[3] = bfhi(a[q].y); nv[4] = bflo(a[q].z); nv[5] = bfhi(a[q].z); nv[6] = bflo(a[q].w); nv[7] = bfhi(a[q].w);
                x1[0] = bflo(b1[q]); x1[1] = bfhi(b1[q]); x2[0] = bflo(b2[q]); x2[1] = bfhi(b2[q]);
                float s = x1[0] * x1[0] + x1[1] * x1[1] + x2[0] * x2[0] + x2[1] * x2[1];
#pragma unroll
                for (int i = 0; i < 8; ++i) s += nv[i] * nv[i];
                s += __shfl_xor(s, 1); s += __shfl_xor(s, 2); s += __shfl_xor(s, 4);
                const float* gn = isq[q] ? gqn : gkn;
                const float rr = rsqrtf(s * (1.f / 96.f) + EPS) * (isq[q] ? QS : 1.f);
                v4u o; float t8[8];
#pragma unroll
                for (int i = 0; i < 8; ++i) t8[i] = nv[i] * rr * gn[8 * sub + i];
                o.x = pk2(t8[0], t8[1]); o.y = pk2(t8[2], t8[3]); o.z = pk2(t8[4], t8[5]); o.w = pk2(t8[6], t8[7]);
                float r1[2], r2[2];
#pragma unroll
                for (int i = 0; i < 2; ++i) { const int fi = 2 * sub + i; const float cs = ROPE[(pos[q] * 16 + fi) * 2], sn = ROPE[(pos[q] * 16 + fi) * 2 + 1];
                    const float aa = x1[i] * rr * gn[64 + fi], bb = x2[i] * rr * gn[80 + fi]; r1[i] = aa * cs - bb * sn; r2[i] = aa * sn + bb * cs; }
                if (val[q]) {
                    if (isq[q]) { bf16* p = QRAW + (size_t)row[q] * 768 + hd * 96; *(v4u*)(p + 8 * sub) = o; *(unsigned*)(p + 64 + 2 * sub) = pk2(r1[0], r1[1]); *(unsigned*)(p + 80 + 2 * sub) = pk2(r2[0], r2[1]); }
                    else { bf16* p = KVRAW + (size_t)row[q] * 1024 + hd * 128; *(v4u*)(p + 8 * sub) = o; bf16* qq = KR + (size_t)row[q] * 256 + hd * 32; *(unsigned*)(qq + 2 * sub) = pk2(r1[0], r1[1]); *(unsigned*)(qq + 16 + 2 * sub) = pk2(r2[0], r2[1]); }
                }
            }
        }
    }
    SEAM(6);
    if (RUN(7)) for (int rep = 0; rep < NREP(7); ++rep) {
        for (int u = bx; u < 256; u += G) { const int b = u >> 3, h = u & 7;
            attn::Tensors T{RAW, 4096, C_FQ + h * 64, RAW, 4096, C_FK + h * 64, C_FV + h * 64, RAW, 4096, 0, AF, 512, h * 64, LOGF, h, args.in[9], args.in[10]};
            attn::attn_bh<64, true>(lds, T, b); }
        for (int u = bx; u < 256; u += G) { const int b = u >> 3, h = u & 7;
            attn::Tensors T{QRAW, 768, h * 96, KVRAW, 1024, h * 128, h * 128 + 64, KR, 256, h * 32, AM, 512, h * 64, nullptr, 0, nullptr, nullptr};
            attn::attn_bh<96, false>(lds, T, b); }
    }
    SEAM(7);
    if (RUN(8)) {
        { pg8::Gemm g{AF, WBF, MROWS, 1024, 512, 512}; pg8::StaticOrder S; S.init(MROWS, 1024, G, bx);
          epi::EpiGate<0> E{TT, MIX, RAW, args.in[8], C_GATE}; pg8::gemm_phase<epi::EpiGate<0>, pg8::StaticOrder, true, true>(lds, g, S, E); }
        { pg8::Gemm g{AM, WBM, MROWS, 1024, 512, 512}; pg8::StaticOrder S; S.init(MROWS, 1024, G, bx);
          epi::EpiGate<1> E{TT, MIX, RAW, args.in[8] + 1024, C_GATE + 1024}; pg8::gemm_phase<epi::EpiGate<1>, pg8::StaticOrder, true, true>(lds, g, S, E); }
    }
    SEAM(8);
    if (RUN(9)) { pg8::Gemm g{MIX, WOUT, MROWS, 1024, 1024, 1024}; pg8::StaticOrder S; S.init(MROWS, 1024, G, bx);
        epi::EpiRes<false, true, false, true, true> E{nullptr, AB, nullptr, AB, SS2}; pg8::gemm_phase<epi::EpiRes<false, true, false, true, true>, pg8::StaticOrder, true, true>(lds, g, S, E); }
    SEAM(9);
    if (RUN(10)) { pg8::Gemm g{AB, WGU2, MROWS, 5632, 1024, 1024}; pg8::StaticOrder S; S.init(MROWS, 5632, G, bx);
        RS_FILL(S, SS2);
        epi::EpiSwiglu<-1> E{HMID, 2816, SS2, RS_TABLE(SS2)}; pg8::gemm_phase<epi::EpiSwiglu<-1>, pg8::StaticOrder, true, true>(lds, g, S, E); }
    SEAM(10);
    if (RUN(11)) { pg8::Gemm g{HMID, WD2, MROWS, 1024, 2816, 2816}; pg8::StaticOrder S; S.init(MROWS, 1024, G, bx);
        epi::EpiRes<true, true, true, false, false> E{nullptr, AB, out, nullptr, nullptr}; pg8::gemm_phase<epi::EpiRes<true, true, true, false, false>, pg8::StaticOrder, true, true>(lds, g, S, E); }
#if defined(DUMP_MIB)
    cg::this_grid().sync();
    { const size_t n = (size_t)MROWS * 1024; const unsigned char* src = ws + (size_t)DUMP_MIB * MiB;
      for (size_t i = (size_t)bx * 512 + tid; i < n; i += (size_t)G * 512)
          out[i] = DUMP_F32 ? ((const float*)src)[i] : __uint_as_float((unsigned)((const bf16*)src)[i] << 16); }
#endif
#undef IN
#undef SEAM
}

extern "C" void kernel_launch(void* const* d_in, const int* in_sizes, int n_in, void* d_out, int out_size, void* d_ws, size_t ws_size, hipStream_t stream) {
    static int grid = 0;
    if (grid == 0) {
        if (n_in != 23 || out_size != MROWS * 1024 || ws_size < WS_END) { fprintf(stderr, "kernel_launch: unexpected shapes (n_in %d out %d ws %zu)\n", n_in, out_size, ws_size); grid = -1; return; }
        int dev = 0, cus = 0, per_cu = 0;
        (void)hipGetDevice(&dev); (void)hipDeviceGetAttribute(&cus, hipDeviceAttributeMultiprocessorCount, dev);
        if (hipFuncSetAttribute((const void*)fwd_kernel, hipFuncAttributeMaxDynamicSharedMemorySize, LDS_BYTES) != hipSuccess) { fprintf(stderr, "kernel_launch: hipFuncSetAttribute failed\n"); grid = -1; return; }
        if (hipOccupancyMaxActiveBlocksPerMultiprocessor(&per_cu, (const void*)fwd_kernel, NWAVES * 64, LDS_BYTES) != hipSuccess || per_cu < 1) { fprintf(stderr, "kernel_launch: occupancy query says %d\n", per_cu); per_cu = 1; }
        (void)hipGetLastError();
        grid = cus > 0 ? cus : 256;
    }
    if (grid < 0) return;
    Args a{};
    for (int i = 0; i < 23; ++i) a.in[i] = (const float*)d_in[i];
    a.out = (float*)d_out; a.ws = (unsigned char*)d_ws;
#if MK_N_LAUNCHES == 1
    a.ph_lo = 0; a.ph_hi = NPHASE;
    void* kargs[] = {&a};
    hipError_t e = hipLaunchCooperativeKernel((const void*)fwd_kernel, dim3(grid), dim3(NWAVES * 64), kargs, LDS_BYTES, stream);
    if (e != hipSuccess) fprintf(stderr, "kernel_launch: cooperative launch failed: %s (grid %d)\n", hipGetErrorString(e), grid);
#else
    for (int p = 0; p < NPHASE; ++p) { a.ph_lo = p; a.ph_hi = p + 1;
        hipLaunchKernelGGL(fwd_kernel, dim3(grid), dim3(NWAVES * 64), LDS_BYTES, stream, a); }
#endif
}
```

```cpp
#include <hip/hip_runtime.h>
#include <hip/hip_cooperative_groups.h>
#include <cstdio>
#include <cstdint>
namespace cg = cooperative_groups;
#define MK_N_LAUNCHES 1
#define STOP_PHASE 12
#define SKIP_MASK 0
namespace pg8 {
#define PG8_LAS __attribute__((address_space(3)))
typedef unsigned short bf16_t;
typedef short bf16x8 __attribute__((ext_vector_type(8)));
typedef float f32x4 __attribute__((ext_vector_type(4)));
typedef unsigned u32x4 __attribute__((ext_vector_type(4)));
constexpr int BM = 256, BK = 64, HALF = 128, HTB = HALF * BK * 2  , STAGE_BYTES = 8 * HTB, NXCD = 8, WGM = 8;

__host__ __device__ __forceinline__ int lds_byte(int r, int c) { const int st = (r >> 4) * 2 + (c >> 5), rr = r & 15, cc = c & 31, ob = rr * 64 + cc * 2; return st * 1024 + (ob ^ (((ob >> 9) & 1) << 5)); }
__host__ __device__ __forceinline__ void stage_rc(int b, int& R, int& C) { const int st = b / 1024, sb = b % 1024, swz = sb ^ (((sb >> 9) & 1) << 5); R = (st >> 1) * 16 + swz / 64; C = (st & 1) * 32 + (swz % 64) / 2; }
__host__ __device__ __forceinline__ int perm32(int rho) { const int n = rho >> 4, i = rho & 15; return 8 * (i >> 2) + 4 * n + (i & 3); }

struct Unit { int pm, pn; };
struct Gemm { const bf16_t* A; const bf16_t* Bt; int M, N, K, lda; };

struct StaticOrder {
    int nM, nN, nwg, G, c;
    __host__ __device__ void init(int M, int N, int G_, int c_) { nM = M / BM; nN = N / BM; nwg = nM * nN; G = G_; c = c_; }
    __host__ __device__ bool next(int i, Unit& u) const {
        const long L = (long)i * G + c; if (L >= nwg) return false;
        int wgid = (int)L; { const int q = nwg / NXCD, r = nwg % NXCD, xcd = wgid % NXCD, off = wgid / NXCD; wgid = (xcd < r ? xcd * (q + 1) : r * (q + 1) + (xcd - r) * q) + off; }
        const int nig = WGM * nN, gid = wgid / nig, fm = gid * WGM, gsz = (nM - fm) < WGM ? (nM - fm) : WGM;
        u.pm = fm + ((wgid % nig) % gsz); u.pn = (wgid % nig) / gsz; return true;
    }
    __device__ __forceinline__ void a_ready(const Unit&) const {}
    __device__ __forceinline__ void done(const Unit&) const {}
};
__device__ __forceinline__ unsigned cvt_pk_bf16(float lo, float hi) { unsigned r; asm volatile("v_cvt_pk_bf16_f32 %0, %1, %2" : "=v"(r) : "v"(lo), "v"(hi)); return r; }
typedef float f32x2 __attribute__((ext_vector_type(2)));
template <class Epi, class Sched, bool ALIGN_EPI = false, bool SP2 = false>
__device__ __forceinline__ void gemm_phase(PG8_LAS unsigned char* lds, const Gemm g, const Sched& S, const Epi& E) {
    const int tid = threadIdx.x, wid = __builtin_amdgcn_readfirstlane(tid >> 6), lane = tid & 63, wr = wid >> 2, wc = wid & 3, fr = lane & 15, fq = lane >> 4;
    const int K = g.K, nt = K / BK;
    unsigned voffA[2], voffB[2];
#pragma unroll
    for (int i = 0; i < 2; ++i) { int R, C; stage_rc(tid * 16 + i * 8192, R, C); const int Rb = Epi::PERM ? ((R & ~31) + perm32(R & 31)) : R;
        voffA[i] = (unsigned)(R * g.lda + C) * 2u; voffB[i] = (unsigned)(Rb * K + C) * 2u; }
    const size_t kstep = (size_t)(BK * 2);
    const size_t hstep = (size_t)HALF * K * 2;
    const size_t tstep = 2 * hstep;
    const size_t hstepA = (size_t)HALF * g.lda * 2, tstepA = 2 * hstepA;
    const unsigned ldsw = (unsigned)wid * 1024u;
    const int aoff = lds_byte(wr * 64 + fr, fq * 8), boff = lds_byte(wc * 32 + fr, fq * 8);
#define PG8_SA(b, h) (((b) * 2 + (h)) * HTB)
#define PG8_SB(b, h) ((4 + (b) * 2 + (h)) * HTB)
#define PG8_STAGE(bufoff, gbase, voff) do { _Pragma("unroll") for (int _i = 0; _i < 2; ++_i) \
        __builtin_amdgcn_global_load_lds((const unsigned*)((const char*)(gbase) + (voff)[_i]), (PG8_LAS unsigned*)(lds + (bufoff) + ldsw + _i * 8192), 16, 0, 0); } while (0)
#define PG8_LDA(dst, b, h) do { _Pragma("unroll") for (int m = 0; m < 4; ++m) _Pragma("unroll") for (int k = 0; k < 2; ++k) dst[m][k] = *(const PG8_LAS bf16x8*)(lds + PG8_SA(b, h) + aoff + m * 2048 + k * 1024); } while (0)
#define PG8_LDB(dst, b, h) do { _Pragma("unroll") for (int n = 0; n < 2; ++n) _Pragma("unroll") for (int k = 0; k < 2; ++k) dst[n][k] = *(const PG8_LAS bf16x8*)(lds + PG8_SB(b, h) + boff + n * 2048 + k * 1024); } while (0)
#define PG8_MMA(ai, bj, At, Bt) do { __builtin_amdgcn_s_setprio(1); _Pragma("unroll") for (int m = 0; m < 4; ++m) _Pragma("unroll") for (int n = 0; n < 2; ++n) _Pragma("unroll") for (int k = 0; k < 2; ++k) \
        acc[ai][bj][m][n] = __builtin_amdgcn_mfma_f32_16x16x32_bf16(Bt[n][k], At[m][k], acc[ai][bj][m][n], 0, 0, 0); __builtin_amdgcn_s_setprio(0); } while (0)
#define PG8_WAIT_V(n) asm volatile("s_waitcnt vmcnt(" #n ")" ::: "memory")
#define PG8_WAIT_L(n) asm volatile("s_waitcnt lgkmcnt(" #n ")" ::: "memory")
#define PG8_BAR __builtin_amdgcn_s_barrier()
#define PG8_SCHED __builtin_amdgcn_sched_barrier(0)
    Unit cur, nxt; int ui = 0;
    if (!S.next(0, cur)) return;
    f32x4 acc[2][2][4][2];
#pragma unroll
    for (int a = 0; a < 2; ++a)
#pragma unroll
        for (int b = 0; b < 2; ++b)
#pragma unroll
            for (int m = 0; m < 4; ++m)
#pragma unroll
                for (int n = 0; n < 2; ++n) acc[a][b][m][n] = (f32x4){0.f, 0.f, 0.f, 0.f};
    bf16x8 At[4][2], B0[2][2], B1[2][2];
    const char* cA = (const char*)g.A + (size_t)cur.pm * tstepA; const char* cB = (const char*)g.Bt + (size_t)cur.pn * tstep;
    S.a_ready(cur);
    if constexpr (SP2) {
        PG8_STAGE(PG8_SB(0, 0), cB, voffB); PG8_STAGE(PG8_SB(0, 1), cB + hstep, voffB); PG8_STAGE(PG8_SA(0, 0), cA, voffA); PG8_STAGE(PG8_SA(0, 1), cA + hstepA, voffA);
        if (wr == 1) PG8_BAR;
        PG8_WAIT_V(2); PG8_BAR;
        PG8_STAGE(PG8_SB(1, 0), cB + kstep, voffB); PG8_STAGE(PG8_SA(1, 0), cA + kstep, voffA); PG8_STAGE(PG8_SB(1, 1), cB + hstep + kstep, voffB);
        PG8_WAIT_V(6); PG8_BAR;
    } else {
        PG8_STAGE(PG8_SB(0, 0), cB, voffB); PG8_STAGE(PG8_SA(0, 0), cA, voffA); PG8_STAGE(PG8_SB(0, 1), cB + hstep, voffB); PG8_STAGE(PG8_SA(0, 1), cA + hstepA, voffA);
        if (wr == 1) PG8_BAR;
        PG8_WAIT_V(4); PG8_BAR;
        PG8_STAGE(PG8_SB(1, 0), cB + kstep, voffB); PG8_STAGE(PG8_SA(1, 0), cA + kstep, voffA); PG8_STAGE(PG8_SB(1, 1), cB + hstep + kstep, voffB);
        PG8_WAIT_V(6); PG8_BAR;
    }
    for (;;) {
        const bool has_next = S.next(ui + 1, nxt);
        const char* nA = has_next ? (const char*)g.A + (size_t)nxt.pm * tstepA : cA; const char* nB = has_next ? (const char*)g.Bt + (size_t)nxt.pn * tstep : cB;
        for (int t = 0; t < nt; t += 2) {
            const bool last = (t == nt - 2);
            const char* a1 = cA + (size_t)(t + 1) * kstep;
            const char* a2 = last ? nA : cA + (size_t)(t + 2) * kstep; const char* b2 = last ? nB : cB + (size_t)(t + 2) * kstep;
            const char* a3 = a2 + kstep; const char* b3 = b2 + kstep;
            if (last && has_next) S.a_ready(nxt);
            if constexpr (SP2) {
            PG8_LDB(B0, 0, 0); PG8_LDB(B1, 0, 1); PG8_SCHED; PG8_LDA(At, 0, 0); PG8_STAGE(PG8_SA(1, 1), a1 + hstepA, voffA);
            PG8_WAIT_V(8); PG8_WAIT_L(0); PG8_BAR; PG8_MMA(0, 0, At, B0); PG8_MMA(0, 1, At, B1); PG8_BAR; PG8_SCHED;
            PG8_LDA(At, 0, 1); PG8_STAGE(PG8_SB(0, 0), b2, voffB); PG8_STAGE(PG8_SB(0, 1), b2 + hstep, voffB); PG8_STAGE(PG8_SA(0, 0), a2, voffA);
            PG8_WAIT_V(8); PG8_WAIT_L(0); PG8_BAR; PG8_MMA(1, 0, At, B0); PG8_MMA(1, 1, At, B1); PG8_BAR; PG8_SCHED;
            PG8_LDB(B0, 1, 0); PG8_LDB(B1, 1, 1); PG8_SCHED; PG8_LDA(At, 1, 0); PG8_STAGE(PG8_SA(0, 1), a2 + hstepA, voffA);
            PG8_WAIT_V(8); PG8_WAIT_L(0); PG8_BAR; PG8_MMA(0, 0, At, B0); PG8_MMA(0, 1, At, B1); PG8_BAR; PG8_SCHED;
            PG8_LDA(At, 1, 1); PG8_STAGE(PG8_SB(1, 0), b3, voffB); PG8_STAGE(PG8_SB(1, 1), b3 + hstep, voffB); PG8_STAGE(PG8_SA(1, 0), a3, voffA);
            PG8_WAIT_V(8); PG8_WAIT_L(0); PG8_BAR; PG8_MMA(1, 0, At, B0); PG8_MMA(1, 1, At, B1); PG8_BAR; PG8_SCHED;
            } else {
            PG8_LDB(B0, 0, 0); PG8_SCHED; PG8_LDA(At, 0, 0); PG8_STAGE(PG8_SA(1, 1), a1 + hstepA, voffA);
            PG8_WAIT_L(8); PG8_BAR; PG8_WAIT_L(0); PG8_MMA(0, 0, At, B0); PG8_BAR; PG8_SCHED;
            PG8_LDB(B1, 0, 1); PG8_STAGE(PG8_SB(0, 0), b2, voffB);
            PG8_BAR; PG8_WAIT_L(0); PG8_MMA(0, 1, At, B1); PG8_BAR;
            PG8_LDA(At, 0, 1); PG8_STAGE(PG8_SA(0, 0), a2, voffA);
            PG8_BAR; PG8_WAIT_L(0); PG8_MMA(1, 0, At, B0); PG8_BAR; PG8_SCHED;
            PG8_STAGE(PG8_SB(0, 1), b2 + hstep, voffB);
            PG8_WAIT_V(6); PG8_BAR; PG8_MMA(1, 1, At, B1); PG8_BAR;
            PG8_LDB(B0, 1, 0); PG8_SCHED; PG8_LDA(At, 1, 0); PG8_STAGE(PG8_SA(0, 1), a2 + hstepA, voffA);
            PG8_WAIT_L(8); PG8_BAR; PG8_WAIT_L(0); PG8_MMA(0, 0, At, B0); PG8_BAR; PG8_SCHED;
            PG8_LDB(B1, 1, 1); PG8_STAGE(PG8_SB(1, 0), b3, voffB);
            PG8_BAR; PG8_WAIT_L(0); PG8_MMA(0, 1, At, B1); PG8_BAR;
            PG8_LDA(At, 1, 1); PG8_STAGE(PG8_SA(1, 0), a3, voffA);
            PG8_BAR; PG8_WAIT_L(0); PG8_MMA(1, 0, At, B0); PG8_BAR; PG8_SCHED;
            PG8_STAGE(PG8_SB(1, 1), b3 + hstep, voffB);
            PG8_WAIT_V(6); PG8_BAR; PG8_MMA(1, 1, At, B1); PG8_BAR;
            }
        }
        if constexpr (ALIGN_EPI) { if (wr == 0) PG8_BAR; }
        if constexpr (!Epi::AFTER_DRAIN) { E(acc, cur, wr, wc, fr, fq); S.done(cur); }
        if (!has_next) break;
#pragma unroll
        for (int a = 0; a < 2; ++a)
#pragma unroll
            for (int b = 0; b < 2; ++b)
#pragma unroll
                for (int m = 0; m < 4; ++m)
#pragma unroll
                    for (int n = 0; n < 2; ++n) acc[a][b][m][n] = (f32x4){0.f, 0.f, 0.f, 0.f};
        cur = nxt; cA = nA; cB = nB; ++ui;
        if constexpr (ALIGN_EPI) { if (wr == 1) PG8_BAR; }
    }
    PG8_WAIT_V(0);
    if constexpr (!ALIGN_EPI) { if (wr == 0) PG8_BAR; }
    PG8_BAR;
    if constexpr (Epi::AFTER_DRAIN) { E.fused(acc, cur, wr, wc, fr, fq, lds, wid, lane); S.done(cur); }
#undef PG8_SA
#undef PG8_SB
#undef PG8_STAGE
#undef PG8_LDA
#undef PG8_LDB
#undef PG8_MMA
#undef PG8_WAIT_V
#undef PG8_WAIT_L
#undef PG8_BAR
#undef PG8_SCHED
}
}

constexpr int MROWS = 65536;
constexpr int MROWS1 = 65792;
constexpr int NMETA = 16, SEQ = 2048, DMODEL = 1024, DFF = 2816;
constexpr float EPS = 1e-6f;
constexpr float L2E = 1.4426950408889634f;

namespace epi {
using pg8::f32x4; using pg8::u32x4; using pg8::bf16_t; using pg8::Unit; using pg8::cvt_pk_bf16;
__device__ __forceinline__ u32x4 pack8(const f32x4 a, const f32x4 b) { u32x4 w; w.x = cvt_pk_bf16(a[0], a[1]); w.y = cvt_pk_bf16(a[2], a[3]); w.z = cvt_pk_bf16(b[0], b[1]); w.w = cvt_pk_bf16(b[2], b[3]); return w; }
__device__ __forceinline__ float sq4(const f32x4 a) { return (a[0] * a[0] + a[1] * a[1]) + (a[2] * a[2] + a[3] * a[3]); }
__device__ __forceinline__ float red_fq(float s) { s += __shfl_xor(s, 16); s += __shfl_xor(s, 32); return s; }
__device__ __forceinline__ float sigm(float z) { return __builtin_amdgcn_rcpf(1.f + __builtin_amdgcn_exp2f(-z * L2E)); }
__device__ __forceinline__ f32x4 bf4_to_f32(unsigned lo, unsigned hi) { f32x4 r; r[0] = __uint_as_float(lo << 16); r[1] = __uint_as_float(lo & 0xffff0000u); r[2] = __uint_as_float(hi << 16); r[3] = __uint_as_float(hi & 0xffff0000u); return r; }

template <int NP> __device__ __forceinline__ float ss_sum(const float* p, int row) {
    if (NP == 1) return p[row];
    float s = 0.f;
#pragma unroll
    for (int i = 0; i < NP / 4; ++i) { const f32x4 v = *(const f32x4*)(p + (size_t)row * NP + 4 * i); s += (v[0] + v[1]) + (v[2] + v[3]); }
    return s;
}

#define EPI_LAS __attribute__((address_space(3)))
struct RsTable { const EPI_LAS float* rs; const EPI_LAS int* pm; int cnt; const float* ssp; };
__device__ __forceinline__ float rs_lookup(const RsTable& t, int pm, int rin, int row) {
    int slot = -1;
    for (int k = 0; k < t.cnt; ++k) if (t.pm[k] == pm) slot = k;
    if (slot >= 0) return t.rs[slot * 256 + rin];
    return rsqrtf(ss_sum<16>(t.ssp, row) * (1.f / 1024.f) + EPS);
}

template <int NP> struct EpiSwiglu {
    static constexpr bool PERM = true, AFTER_DRAIN = false;
    bf16_t* O; int ldo; const float* ss; RsTable tab;
    __device__ __forceinline__ void operator()(const f32x4 (&acc)[2][2][4][2], const Unit& u, int wr, int wc, int fr, int fq) const {
        const int ocol = u.pn * 128 + wc * 32 + 8 * fq;
#pragma unroll
        for (int ai = 0; ai < 2; ++ai)
#pragma unroll
            for (int m = 0; m < 4; ++m) {
                const int row = u.pm * 256 + ai * 128 + wr * 64 + m * 16 + fr;
                const float rs = (NP == 0) ? 1.f : (NP < 0 ? rs_lookup(tab, u.pm, ai * 128 + wr * 64 + m * 16 + fr, row) : rsqrtf(ss_sum<(NP <= 0 ? 1 : NP)>(ss, row) * (1.f / 1024.f) + EPS));
                f32x4 h[2];
#pragma unroll
                for (int n = 0; n < 2; ++n) { const f32x4 g = acc[ai][0][m][n] * rs, up = acc[ai][1][m][n] * rs;
#pragma unroll
                    for (int i = 0; i < 4; ++i) h[n][i] = g[i] * sigm(g[i]) * up[i]; }
                *(u32x4*)(O + (size_t)row * ldo + ocol) = pack8(h[0], h[1]);
            }
    }
};

template <bool HALF, bool RESB, bool OUTF, bool HASB, bool HASSS> struct EpiRes {
    static constexpr bool PERM = true, AFTER_DRAIN = false;
    const float* resf; const bf16_t* resb; float* outf; bf16_t* outb; float* ss;
    __device__ __forceinline__ void operator()(const f32x4 (&acc)[2][2][4][2], const Unit& u, int wr, int wc, int fr, int fq) const {
        const float coef = HALF ? 0.5f : 1.0f;
#pragma unroll
        for (int ai = 0; ai < 2; ++ai)
#pragma unroll
            for (int m = 0; m < 4; ++m) {
                const int row = u.pm * 256 + ai * 128 + wr * 64 + m * 16 + fr;
                float sq = 0.f;
#pragma unroll
                for (int bj = 0; bj < 2; ++bj) {
                    const size_t off = (size_t)row * 1024 + u.pn * 256 + bj * 128 + wc * 32 + 8 * fq;
                    f32x4 r0, r1;
                    if (RESB) { const u32x4 w = *(const u32x4*)(resb + off); r0 = bf4_to_f32(w.x, w.y); r1 = bf4_to_f32(w.z, w.w); }
                    else { r0 = *(const f32x4*)(resf + off); r1 = *(const f32x4*)(resf + off + 4); }
                    const f32x4 v0 = r0 + acc[ai][bj][m][0] * coef, v1 = r1 + acc[ai][bj][m][1] * coef;
                    if (OUTF) { __builtin_nontemporal_store(v0, (f32x4*)(outf + off)); __builtin_nontemporal_store(v1, (f32x4*)(outf + off + 4)); }
                    if (HASB) *(u32x4*)(outb + off) = pack8(v0, v1);
                    sq += sq4(v0) + sq4(v1);
                }
                if (HASSS) { sq = red_fq(sq); if (fq == 0) ss[(size_t)row * 16 + u.pn * 4 + wc] = sq; }
            }
    }
};

template <int NP> struct EpiRowScale {
    static constexpr bool PERM = true, AFTER_DRAIN = false;
    bf16_t* O; int ldo; const float* ss; float invn; RsTable tab;
    __device__ __forceinline__ void operator()(const f32x4 (&acc)[2][2][4][2], const Unit& u, int wr, int wc, int fr, int fq) const {
#pragma unroll
        for (int ai = 0; ai < 2; ++ai)
#pragma unroll
            for (int m = 0; m < 4; ++m) {
                const int row = u.pm * 256 + ai * 128 + wr * 64 + m * 16 + fr;
                const float rs = NP < 0 ? rs_lookup(tab, u.pm, ai * 128 + wr * 64 + m * 16 + fr, row) : rsqrtf(ss_sum<(NP <= 0 ? 1 : NP)>(ss, row) * invn + EPS);
#pragma unroll
                for (int bj = 0; bj < 2; ++bj) {
                    const int col = u.pn * 256 + bj * 128 + wc * 32 + 8 * fq;
                    *(u32x4*)(O + (size_t)row * ldo + col) = pack8(acc[ai][bj][m][0] * rs, acc[ai][bj][m][1] * rs);
                }
            }
    }
};

template <int MODE> struct EpiGate {
    static constexpr bool PERM = true, AFTER_DRAIN = false;
    bf16_t* T; bf16_t* MIX; const bf16_t* raw; const float* bias; int goff;
    __device__ __forceinline__ void operator()(const f32x4 (&acc)[2][2][4][2], const Unit& u, int wr, int wc, int fr, int fq) const {
        f32x4 bg[2][2];
#pragma unroll
        for (int bj = 0; bj < 2; ++bj)
#pragma unroll
            for (int n = 0; n < 2; ++n) bg[bj][n] = *(const f32x4*)(bias + u.pn * 256 + bj * 128 + wc * 32 + 8 * fq + 4 * n);
#pragma unroll
        for (int ai = 0; ai < 2; ++ai)
#pragma unroll
            for (int m = 0; m < 4; ++m) {
                const int row = u.pm * 256 + ai * 128 + wr * 64 + m * 16 + fr;
#pragma unroll
                for (int bj = 0; bj < 2; ++bj) {
                    const int col = u.pn * 256 + bj * 128 + wc * 32 + 8 * fq;
                    const u32x4 gw = *(const u32x4*)(raw + (size_t)row * 4096 + goff + col);
                    f32x4 g0 = bf4_to_f32(gw.x, gw.y) + bg[bj][0], g1 = bf4_to_f32(gw.z, gw.w) + bg[bj][1];
#pragma unroll
                    for (int i = 0; i < 4; ++i) { g0[i] = sigm(g0[i]); g1[i] = sigm(g1[i]); }
                    f32x4 v0 = acc[ai][bj][m][0] * g0, v1 = acc[ai][bj][m][1] * g1;
                    bf16_t* tp = T + (size_t)row * 1024 + col;
                    if (MODE == 0) { *(u32x4*)tp = pack8(v0, v1); }
                    else { const u32x4 tw = *(const u32x4*)tp; v0 = v0 + bf4_to_f32(tw.x, tw.y); v1 = v1 + bf4_to_f32(tw.z, tw.w); *(u32x4*)(MIX + (size_t)row * 1024 + col) = pack8(v0, v1); }
                }
            }
    }
};
}

namespace attn {
#define ALAS __attribute__((address_space(3)))
typedef unsigned short bf16_t;
typedef short bf16x8 __attribute__((ext_vector_type(8)));
typedef short s16x4 __attribute__((ext_vector_type(4)));
typedef float f32x16 __attribute__((ext_vector_type(16)));
typedef float f32x4 __attribute__((ext_vector_type(4)));
typedef unsigned u32x4 __attribute__((ext_vector_type(4)));
typedef unsigned u32x2 __attribute__((ext_vector_type(2)));
typedef float f32x2_t __attribute__((ext_vector_type(2))); typedef __bf16 bf16x2_t __attribute__((ext_vector_type(2)));
__device__ __forceinline__ unsigned cvtpk(float lo, float hi) { f32x2_t v = {lo, hi}; bf16x2_t b = __builtin_convertvector(v, bf16x2_t); return __builtin_bit_cast(unsigned, b); }
__device__ __forceinline__ s16x4 vtr(const ALAS unsigned char* p) { return __builtin_bit_cast(s16x4, __builtin_amdgcn_ds_read_tr16_b64_v4i16((ALAS s16x4*)p)); }
constexpr float NEGBIG = -1e30f;
constexpr int VP = 144;


struct Tensors {
    const bf16_t* Q; int ldq, qoff;
    const bf16_t* KV; int ldkv, k1off, voff;
    const bf16_t* K2; int ldk2, k2off;
    bf16_t* O; int ldo, ooff;
    const float* logf;
    int hcol;
    const float* gq; const float* gk;
};

__device__ __forceinline__ float pl32max(float m) { auto rr = __builtin_amdgcn_permlane32_swap(__float_as_uint(m), __float_as_uint(m), false, false); return fmaxf(__uint_as_float(rr[0]), __uint_as_float(rr[1])); }
__device__ __forceinline__ float pl32sum(float m) { auto rr = __builtin_amdgcn_permlane32_swap(__float_as_uint(m), __float_as_uint(m), false, false); return __uint_as_float(rr[0]) + __uint_as_float(rr[1]); }

template <int DK, int NH, bool MASK, bool BIAS>
__device__ __forceinline__ void attn_qk(f32x16 (&x)[NH], const ALAS unsigned char* kbase, const ALAS float* tbp, const bf16x8 (&qf)[DK / 16], int r, int h, int kfirst, int qg) {
    constexpr int KP = DK * 2 + 16, NS = DK / 16;
#pragma unroll
    for (int hh = 0; hh < NH; ++hh) {
        if (BIAS) {
#pragma unroll
            for (int g = 0; g < 4; ++g) { const f32x4 a = *(const ALAS f32x4*)(tbp + 32 * hh + 4 * h + 8 * g);
                x[hh][4 * g] = a[0]; x[hh][4 * g + 1] = a[1]; x[hh][4 * g + 2] = a[2]; x[hh][4 * g + 3] = a[3]; }
        } else {
#pragma unroll
            for (int i = 0; i < 16; ++i) x[hh][i] = 0.f;
        }
    }
    { const ALAS unsigned char* kb = kbase + r * KP + h * 16;
      bf16x8 kf[2][NH];
#pragma unroll
      for (int hh = 0; hh < NH; ++hh) kf[0][hh] = *(const ALAS bf16x8*)(kb + hh * 32 * KP);
#pragma unroll
      for (int s = 0; s < NS; ++s) {
          if (s + 1 < NS) {
#pragma unroll
              for (int hh = 0; hh < NH; ++hh) kf[(s + 1) & 1][hh] = *(const ALAS bf16x8*)(kb + hh * 32 * KP + (s + 1) * 32);
          }
#pragma unroll
          for (int hh = 0; hh < NH; ++hh) x[hh] = __builtin_amdgcn_mfma_f32_32x32x16_bf16(kf[s & 1][hh], qf[s], x[hh], 0, 0, 0);
          __builtin_amdgcn_sched_barrier(0);
      } }
    if (MASK) {
#pragma unroll
        for (int hh = 0; hh < NH; ++hh)
#pragma unroll
            for (int i = 0; i < 16; ++i) { const int kv = kfirst + 32 * hh + 4 * h + (i & 3) + 8 * (i >> 2); if (kv > qg) x[hh][i] = NEGBIG; }
    }
}
template <int NH>
__device__ __forceinline__ void attn_pv(f32x16 (&x)[NH], const ALAS unsigned char* vbase, float& lrun, f32x16& o0, f32x16& o1, int h, int q4, int p4, int blk) {
    f32x2_t ps0 = {0.f, 0.f}, ps1 = {0.f, 0.f};
#pragma unroll
    for (int hh = 0; hh < NH; ++hh)
#pragma unroll
        for (int i = 0; i < 16; i += 4) {
            x[hh][i] = __builtin_amdgcn_exp2f(x[hh][i]); x[hh][i + 1] = __builtin_amdgcn_exp2f(x[hh][i + 1]);
            x[hh][i + 2] = __builtin_amdgcn_exp2f(x[hh][i + 2]); x[hh][i + 3] = __builtin_amdgcn_exp2f(x[hh][i + 3]);
            ps0 += (f32x2_t){x[hh][i], x[hh][i + 1]}; ps1 += (f32x2_t){x[hh][i + 2], x[hh][i + 3]}; }
    lrun += (ps0[0] + ps0[1]) + (ps1[0] + ps1[1]);
    const ALAS unsigned char* vb = vbase + (4 * h + q4) * VP + (16 * blk + 4 * p4) * 2;
    s16x4 vl[2][2];
#pragma unroll
    for (int dh = 0; dh < 2; ++dh) { vl[dh][0] = vtr(vb + dh * 64); vl[dh][1] = vtr(vb + 8 * VP + dh * 64); }
#pragma unroll
    for (int st = 0; st < 2 * NH; ++st) {
        const int hh = st >> 1, s2 = st & 1;
        u32x4 pw;
#pragma unroll
        for (int j = 0; j < 4; ++j) pw[j] = cvtpk(x[hh][8 * s2 + 2 * j], x[hh][8 * s2 + 2 * j + 1]);
        const bf16x8 pf = __builtin_bit_cast(bf16x8, pw);
        const bf16x8 vf0 = __builtin_shufflevector(vl[0][0], vl[0][1], 0, 1, 2, 3, 4, 5, 6, 7);
        const bf16x8 vf1 = __builtin_shufflevector(vl[1][0], vl[1][1], 0, 1, 2, 3, 4, 5, 6, 7);
        o0 = __builtin_amdgcn_mfma_f32_32x32x16_bf16(vf0, pf, o0, 0, 0, 0);
        o1 = __builtin_amdgcn_mfma_f32_32x32x16_bf16(vf1, pf, o1, 0, 0, 0);
        if (st + 1 < 2 * NH) {
#pragma unroll
            for (int dh = 0; dh < 2; ++dh) { vl[dh][0] = vtr(vb + (16 * (st + 1)) * VP + dh * 64); vl[dh][1] = vtr(vb + (16 * (st + 1) + 8) * VP + dh * 64); }
        }
        __builtin_amdgcn_sched_barrier(0);
    }
}

template <int DK, int NH, bool MASK, bool BIAS>
__device__ __forceinline__ void attn_step(const ALAS unsigned char* kbase, const ALAS unsigned char* vbase, const ALAS float* tbp, const bf16x8 (&qf)[DK / 16],
                                          float& mrun, float& lrun, f32x16& o0, f32x16& o1, int r, int h, int q4, int p4, int blk, int kfirst, int qg) {
    f32x16 x[NH]; attn_qk<DK, NH, MASK, BIAS>(x, kbase, tbp, qf, r, h, kfirst, qg); attn_pv<NH>(x, vbase, lrun, o0, o1, h, q4, p4, blk);
}

constexpr int A2_KS = 0, A2_VS = 2 * 128 * 208, A2_CUM = A2_VS + 2 * 128 * VP, A2_TB = A2_CUM + 2080 * 4, A2_SC = A2_TB + 2112 * 4, A2_MK = A2_SC + 64, A2_MV = A2_MK + 32 * 208, ATTN2_LDS = A2_MV + 32 * VP;

template <int DK, bool DECAY>
__device__ __forceinline__ void attn_bh(ALAS unsigned char* lds, const Tensors& T, int b) {
    constexpr int KP = DK * 2 + 16, NS = DK / 16;
    const int tid = threadIdx.x, lane = tid & 63, r = lane & 31, h = lane >> 5;
    const int w = __builtin_amdgcn_readfirstlane(tid >> 6);
    ALAS float* cum = (ALAS float*)(lds + A2_CUM);
    ALAS float* tb = (ALAS float*)(lds + A2_TB);
    ALAS float* sc = (ALAS float*)(lds + A2_SC);
    const size_t rowbase = (size_t)b * SEQ;
    if (DECAY) {
        float v[4];
#pragma unroll
        for (int i = 0; i < 4; ++i) v[i] = T.logf[(rowbase + 4 * tid + i) * 8 + T.hcol];
        v[1] += v[0]; v[2] += v[1]; v[3] += v[2];
        float s = v[3];
#pragma unroll
        for (int o = 1; o < 64; o <<= 1) { const float n = __shfl_up(s, o); if (lane >= o) s += n; }
        if (lane == 63) sc[w] = s;
        __syncthreads();
        float base = s - v[3];
        for (int i = 0; i < w; ++i) base += sc[i];
#pragma unroll
        for (int i = 0; i < 4; ++i) cum[NMETA + 4 * tid + i] = base + v[i];
        if (tid < NMETA) { float a = 0.f; for (int j = tid + 1; j < NMETA; ++j) a += T.logf[((size_t)MROWS + j) * 8 + T.hcol]; cum[tid] = -a; }
        __syncthreads();
    }
    float TSKIP = 3.0e38f;
    if (DECAY) { float a = 0.f, c = 0.f; for (int i = 0; i < 64; ++i) { a = fmaxf(a, fabsf(T.gq[i])); c = fmaxf(c, fabsf(T.gk[i])); }
        const float QB = 8.f * a * c * L2E * 1.01f; TSKIP = (37.f + 2.f * QB) * 0.6931471805599453f; }
    const int q4 = (lane & 15) >> 2, p4 = lane & 3, blk = (lane >> 4) & 1;
    const int vr0 = tid >> 3, vc = tid & 7, k2r = tid >> 2, k2c = tid & 3;
    const unsigned kvo = (unsigned)(vr0 * T.ldkv + 8 * vc) * 2u, k2o = (unsigned)(k2r * T.ldk2 + 8 * k2c) * 2u;
    const char* kvb = (const char*)T.KV; const char* k2b = (const char*)T.K2;
    for (int qb = 7; qb >= 0; --qb) {
        const int q0 = qb * 256, NST = 2 * qb + 2;
        int st_min = 0; bool skip_meta = false;
        if (DECAY) { const float cq0 = cum[NMETA + q0]; while (st_min < NST - 2 && cum[NMETA + 128 * st_min + 127] - cq0 >= TSKIP) ++st_min; skip_meta = (-cq0 >= TSKIP); }
        unsigned kvo_ = kvo, k2o_ = k2o; int rq_ = r; asm volatile("" : "+v"(kvo_), "+v"(k2o_), "+v"(rq_));
        { const float cref = DECAY ? cum[NMETA + q0 + 128] : 0.f;
          for (int idx = tid; idx < 32 + 128 * NST; idx += 512) { float val;
              if (idx < 32) val = (idx < NMETA) ? (DECAY ? (cref - cum[idx]) * L2E : 0.f) : NEGBIG;
              else val = DECAY ? (cref - cum[NMETA + idx - 32]) * L2E : 0.f;
              tb[idx] = val; } }
        bf16x8 qf[NS];
        { const bf16_t* qp = T.Q + (rowbase + q0 + 32 * w + rq_) * T.ldq + T.qoff + 8 * h;
#pragma unroll
          for (int s = 0; s < NS; ++s) qf[s] = *(const bf16x8*)(qp + 16 * s); }
        u32x4 kreg[2], k2reg = (u32x4){0u, 0u, 0u, 0u}, vreg[2];
#define AT_KVB(row_, off_) (kvb + ((size_t)(row_) * T.ldkv + (off_)) * 2)
#define AT_GLOAD_K(st_) do { _Pragma("unroll") for (int i_ = 0; i_ < 2; ++i_) kreg[i_] = *(const u32x4*)(AT_KVB(rowbase + 128 * (st_) + 64 * i_, T.k1off) + kvo_); \
            if (DK == 96) k2reg = *(const u32x4*)(k2b + ((size_t)(rowbase + 128 * (st_)) * T.ldk2 + T.k2off) * 2 + k2o_); } while (0)
#define AT_GLOAD_V(st_) do { _Pragma("unroll") for (int i_ = 0; i_ < 2; ++i_) vreg[i_] = *(const u32x4*)(AT_KVB(rowbase + 128 * (st_) + 64 * i_, T.voff) + kvo_); } while (0)
#define AT_LSTORE_K(buf_) do { _Pragma("unroll") for (int i_ = 0; i_ < 2; ++i_) *(ALAS u32x4*)(lds + A2_KS + (buf_) * 128 * KP + (vr0 + 64 * i_) * KP + vc * 16) = kreg[i_]; \
            if (DK == 96) *(ALAS u32x4*)(lds + A2_KS + (buf_) * 128 * KP + k2r * KP + 128 + k2c * 16) = k2reg; } while (0)
#define AT_LSTORE_V(buf_) do { _Pragma("unroll") for (int i_ = 0; i_ < 2; ++i_) *(ALAS u32x4*)(lds + A2_VS + (buf_) * 128 * VP + (vr0 + 64 * i_) * VP + vc * 16) = vreg[i_]; } while (0)
        { const u32x4 z = (u32x4){0u, 0u, 0u, 0u};
          if (tid < 256) { u32x4 kv = z, vv = z; if (vr0 < NMETA) { kv = *(const u32x4*)(AT_KVB((size_t)MROWS, T.k1off) + kvo_); vv = *(const u32x4*)(AT_KVB((size_t)MROWS, T.voff) + kvo_); }
              *(ALAS u32x4*)(lds + A2_MK + vr0 * KP + vc * 16) = kv; *(ALAS u32x4*)(lds + A2_MV + vr0 * VP + vc * 16) = vv; }
          if (DK == 96 && tid < 128) { u32x4 kv = z; if (k2r < NMETA) kv = *(const u32x4*)(k2b + ((size_t)MROWS * T.ldk2 + T.k2off) * 2 + k2o_);
              *(ALAS u32x4*)(lds + A2_MK + k2r * KP + 128 + k2c * 16) = kv; } }
        AT_GLOAD_K(st_min); AT_GLOAD_V(st_min);
        __syncthreads();
        float mrun = NEGBIG, lrun = 0.f;
        f32x16 o0, o1;
#pragma unroll
        for (int i = 0; i < 16; ++i) { o0[i] = 0.f; o1[i] = 0.f; }
        const int qg = q0 + 32 * w + r;
        if (!skip_meta) attn_step<DK, 1, false, true>(lds + A2_MK, lds + A2_MV, tb, qf, mrun, lrun, o0, o1, r, h, q4, p4, blk, 0, qg);
        if (st_min & 1) { AT_LSTORE_K(0); AT_LSTORE_V(0); } else { AT_LSTORE_K(1); AT_LSTORE_V(1); }
        if (st_min + 1 < NST) { AT_GLOAD_K(st_min + 1); AT_GLOAD_V(st_min + 1); }
        __syncthreads();
        for (int st = st_min; st < NST; ++st) {
            const int buf = (st + 1) & 1;
            const bool more = st + 1 < NST, more2 = st + 2 < NST;
            const int kt0 = 128 * st;
            if (more) AT_LSTORE_K(st & 1);
            if (more2) AT_GLOAD_K(st + 2);
            {
                const ALAS unsigned char* kb = lds + A2_KS + buf * 128 * KP; const ALAS unsigned char* vb = lds + A2_VS + buf * 128 * VP;
                const int wq0 = q0 + 32 * w;
                const bool act0 = kt0 <= wq0 + 31, act1 = kt0 + 64 <= wq0 + 31;
                f32x16 xa[2], xb[2];
                if (act0) { if (kt0 + 63 > wq0) attn_qk<DK, 2, true, DECAY>(xa, kb, tb + 32 + kt0, qf, r, h, kt0, qg); else attn_qk<DK, 2, false, DECAY>(xa, kb, tb + 32 + kt0, qf, r, h, kt0, qg); }
                if (act1) { if (kt0 + 127 > wq0) attn_qk<DK, 2, true, DECAY>(xb, kb + 64 * KP, tb + 96 + kt0, qf, r, h, kt0 + 64, qg); else attn_qk<DK, 2, false, DECAY>(xb, kb + 64 * KP, tb + 96 + kt0, qf, r, h, kt0 + 64, qg); }
                __builtin_amdgcn_sched_barrier(0);
                if (more) AT_LSTORE_V(st & 1); if (more2) AT_GLOAD_V(st + 2);
                if (act0) attn_pv<2>(xa, vb, lrun, o0, o1, h, q4, p4, blk);
                if (act1) attn_pv<2>(xb, vb + 64 * VP, lrun, o0, o1, h, q4, p4, blk);
            }
            __syncthreads();
        }
        lrun = pl32sum(lrun);
        const float inv = 1.f / lrun;
        bf16_t* op = T.O + (rowbase + q0 + 32 * w + rq_) * T.ldo + T.ooff + 4 * h;
#pragma unroll
        for (int g = 0; g < 4; ++g) {
            u32x2 a, c;
            a.x = cvtpk(o0[4 * g] * inv, o0[4 * g + 1] * inv); a.y = cvtpk(o0[4 * g + 2] * inv, o0[4 * g + 3] * inv);
            c.x = cvtpk(o1[4 * g] * inv, o1[4 * g + 1] * inv); c.y = cvtpk(o1[4 * g + 2] * inv, o1[4 * g + 3] * inv);
            *(u32x2*)(op + 8 * g) = a; *(u32x2*)(op + 32 + 8 * g) = c;
        }
    }
    __syncthreads();
}
#undef AT_KVB
#undef AT_GLOAD_K
#undef AT_GLOAD_V
#undef AT_LSTORE_K
#undef AT_LSTORE_V
}

#define LAS __attribute__((address_space(3)))
typedef unsigned short bf16;
typedef unsigned v4u __attribute__((ext_vector_type(4)));
typedef unsigned v2u __attribute__((ext_vector_type(2)));
typedef float f32x4 __attribute__((ext_vector_type(4)));
constexpr int NWAVES = 8;
constexpr int LDS_BYTES = 147456;
constexpr int RING_BYTES = 131072;
static_assert(attn::ATTN2_LDS <= RING_BYTES, "attention LDS");
#ifndef MK_N_LAUNCHES
#define MK_N_LAUNCHES 1
#endif
#ifndef STOP_PHASE
#define STOP_PHASE 12
#endif
constexpr int NPHASE = STOP_PHASE;


constexpr size_t MiB = 1u << 20;
constexpr size_t WS_SS0 = 0, WS_SSCQ = MiB / 2, WS_SSCKV = MiB, WS_BAR = 2 * MiB, WS_ROPE = 3 * MiB;
constexpr size_t WS_WGU1 = 4 * MiB, WS_WD1 = 15 * MiB, WS_WGU2 = 21 * MiB, WS_WD2 = 32 * MiB, WS_WIN = 38 * MiB, WS_WUQ = 46 * MiB, WS_WUKV = 47 * MiB,
                 WS_WBF = 48 * MiB, WS_WBM = 49 * MiB, WS_WOUT = 50 * MiB;
constexpr size_t WS_AB = 52 * MiB;
constexpr size_t WS_AF = 52 * MiB, WS_AM = 116 * MiB;
constexpr size_t WS_HMID = 181 * MiB;
constexpr size_t WS_RAW = 181 * MiB;
constexpr size_t WS_QRAW = 695 * MiB, WS_KVRAW = 791 * MiB, WS_KR = 920 * MiB, WS_LOGF = 953 * MiB, WS_SS1P = 956 * MiB, WS_SS2P = 961 * MiB, WS_END = 966 * MiB;
constexpr size_t WS_T = 695 * MiB, WS_MIX = 823 * MiB;
static_assert(WS_AB + (size_t)MROWS1 * 1024 * 2 <= WS_HMID && WS_HMID + (size_t)MROWS1 * 2816 * 2 <= WS_QRAW && WS_RAW + (size_t)MROWS1 * 4096 * 2 <= WS_QRAW &&
              WS_QRAW + (size_t)MROWS * 768 * 2 <= WS_KVRAW && WS_KVRAW + (size_t)MROWS1 * 1024 * 2 <= WS_KR && WS_KR + (size_t)MROWS1 * 256 * 2 <= WS_LOGF &&
              WS_LOGF + (size_t)MROWS1 * 32 <= WS_SS1P && WS_SS1P + (size_t)MROWS1 * 64 <= WS_SS2P && WS_SS2P + (size_t)MROWS1 * 64 <= WS_END &&
              WS_T + (size_t)MROWS * 1024 * 2 <= WS_MIX && WS_MIX + (size_t)MROWS * 1024 * 2 <= WS_LOGF && WS_AM + (size_t)MROWS * 512 * 2 <= WS_HMID, "d_ws map");

#define XB_TMO      128
#define XB_XCNT(j)  (256  + 64 * (j))
#define XB_XSUB(j)  (1280 + 64 * (j))
#define XB_XGEN(j)  (2304 + 64 * (j))
#define XB_TOP      3328
#define XB_TOPGEN   3392
#define XCD_BAR_WORDS 3456
#define XB_SPIN_CAP (1u << 18)

__device__ __forceinline__ unsigned xb_ld(unsigned* p)              { return __hip_atomic_load(p, __ATOMIC_RELAXED, __HIP_MEMORY_SCOPE_AGENT); }
__device__ __forceinline__ unsigned xb_add(unsigned* p, unsigned v) { return __hip_atomic_fetch_add(p, v, __ATOMIC_RELAXED, __HIP_MEMORY_SCOPE_AGENT); }
__device__ __forceinline__ unsigned xb_xcc_id() { return (unsigned)__builtin_amdgcn_s_getreg((3 << 11) | 20) & 0xFu; }
#define XB_SPIN(cond, bar) do { unsigned _sp = 0; while (cond) { __builtin_amdgcn_s_sleep(1); \
    if ((++_sp & 255u) == 0u) { if (xb_ld(&(bar)[XB_TMO])) break; if (_sp > XB_SPIN_CAP) { atomicAdd(&(bar)[XB_TMO], 1u); break; } } } } while (0)

struct XcdBarrier {
    unsigned* bar; unsigned x;
    volatile LAS unsigned* st;
};

__device__ __forceinline__ XcdBarrier xcd_barrier_post(unsigned* bar, volatile LAS unsigned* st) {
    XcdBarrier b; b.bar = bar; b.x = xb_xcc_id(); b.st = st;
    if (threadIdx.x == 0) (void)xb_add(&bar[XB_XCNT(b.x)], 1u);
    return b;
}
__device__ __forceinline__ void xcd_barrier_complete(unsigned* bar, unsigned x, unsigned& nloc, unsigned& nx) {
    const unsigned G = gridDim.x * gridDim.y * gridDim.z;
    unsigned sum, cnt, mine, sp = 0u;
    for (;;) {
        sum = 0u; cnt = 0u; mine = 0u;
#pragma unroll
        for (unsigned j = 0; j < 16; ++j) { const unsigned c = xb_ld(&bar[XB_XCNT(j)]); sum += c; cnt += (c > 0u) ? 1u : 0u; mine = (j == x) ? c : mine; }
        if (sum == G) break;
        __builtin_amdgcn_s_sleep(1);
        if ((++sp & 255u) == 0u) { if (xb_ld(&bar[XB_TMO])) break; if (sp > XB_SPIN_CAP) { atomicAdd(&bar[XB_TMO], 1u); break; } }
    }
    nloc = mine > 0u ? mine : 1u; nx = cnt > 0u ? cnt : 1u;
}

__device__ __forceinline__ void xcd_barrier(const XcdBarrier& b) {
    asm volatile("s_waitcnt vmcnt(0)" ::: "memory");
    __syncthreads();
    if (threadIdx.x == 0) {
        unsigned* bar = b.bar;
        __builtin_amdgcn_s_waitcnt(0);
        unsigned nloc = b.st[0], nx = b.st[1];
        if (nloc == 0u) { xcd_barrier_complete(bar, b.x, nloc, nx); b.st[0] = nloc; b.st[1] = nx; }
        const unsigned old = xb_add(&bar[XB_XSUB(b.x)], 1u);
        const unsigned gen = old / nloc;
        if (old + 1u == (gen + 1u) * nloc) {
            __builtin_amdgcn_fence(__ATOMIC_RELEASE, "agent");
            asm volatile("s_waitcnt vmcnt(0)" ::: "memory");
            const unsigned og = xb_add(&bar[XB_TOP], 1u);
            const unsigned tg = og / nx;
            if (og + 1u == (tg + 1u) * nx) xb_add(&bar[XB_TOPGEN], 1u);
            else XB_SPIN(xb_ld(&bar[XB_TOPGEN]) == tg, bar);
            __builtin_amdgcn_fence(__ATOMIC_ACQUIRE, "agent");
            xb_add(&bar[XB_XGEN(b.x)], 1u);
            asm volatile("s_waitcnt vmcnt(0)" ::: "memory");
        } else {
            XB_SPIN(xb_ld(&bar[XB_XGEN(b.x)]) == gen, bar);
            __builtin_amdgcn_fence(__ATOMIC_ACQUIRE, "agent");
            asm volatile("s_waitcnt vmcnt(0)" ::: "memory");
        }
    }
    __syncthreads();
}

struct Args { const float* in[23]; float* out; unsigned char* ws; int ph_lo, ph_hi; };
static_assert(sizeof(Args) == 26 * 8, "Args has no padding");

__device__ __forceinline__ unsigned f2bf(float f) { unsigned u = __builtin_bit_cast(unsigned, f); return (u + 0x7fffu + ((u >> 16) & 1u)) >> 16; }
__device__ __forceinline__ unsigned pk2(float lo, float hi) { return f2bf(lo) | (f2bf(hi) << 16); }
__device__ __forceinline__ float bflo(unsigned w) { return __uint_as_float(w << 16); }
__device__ __forceinline__ float bfhi(unsigned w) { return __uint_as_float(w & 0xffff0000u); }
__device__ __forceinline__ float wave_sum(float v) {
#pragma unroll
    for (int o = 1; o < 64; o <<= 1) v += __shfl_xor(v, o);
    return v;
}
__device__ __forceinline__ void tr_item(const float* W, int ldw, int scol0, int nvalid, const float* gain, bf16* WT, int K, int drow0, int k0, LAS float* scr, int lane) {
    const int ng = lane & 7, kr = lane >> 3;
#pragma unroll
    for (int i = 0; i < 8; ++i) { const int kk = 8 * i + kr; f32x4 v = (f32x4){0.f, 0.f, 0.f, 0.f};
        if (4 * ng < nvalid) { v = *(const f32x4*)(W + (size_t)(k0 + kk) * ldw + scol0 + 4 * ng); if (gain) v = v * gain[k0 + kk]; }
        scr[kk * 33 + 4 * ng] = v[0]; scr[kk * 33 + 4 * ng + 1] = v[1]; scr[kk * 33 + 4 * ng + 2] = v[2]; scr[kk * 33 + 4 * ng + 3] = v[3]; }
    asm volatile("s_waitcnt lgkmcnt(0)" ::: "memory");
    const int c = lane & 7;
#pragma unroll
    for (int j = 0; j < 4; ++j) { const int n = (lane >> 3) + 8 * j; const LAS float* s = scr + (8 * c) * 33 + n;
        v4u o; o.x = pk2(s[0 * 33], s[1 * 33]); o.y = pk2(s[2 * 33], s[3 * 33]); o.z = pk2(s[4 * 33], s[5 * 33]); o.w = pk2(s[6 * 33], s[7 * 33]);
        *(v4u*)(WT + (size_t)(drow0 + n) * K + k0 + 8 * c) = o; }
    asm volatile("s_waitcnt lgkmcnt(0)" ::: "memory");
}
typedef short sk_bf16x8 __attribute__((ext_vector_type(8)));
template <int NB> __device__ __forceinline__ void skinny16(const bf16* A, int lda, const bf16* Bt, int ldb, int K, const int (&brow)[NB], f32x4 (&acc)[NB], int lane) {
    const bf16* ap = A + (size_t)(lane & 15) * lda + 8 * (lane >> 4);
    const bf16* bp[NB];
#pragma unroll
    for (int b = 0; b < NB; ++b) { bp[b] = Bt + (size_t)(brow[b] + (lane & 15)) * ldb + 8 * (lane >> 4); acc[b] = (f32x4){0.f, 0.f, 0.f, 0.f}; }
#pragma unroll 4
    for (int k0 = 0; k0 < K; k0 += 32) {
        const sk_bf16x8 a = *(const sk_bf16x8*)(ap + k0);
#pragma unroll
        for (int b = 0; b < NB; ++b) { const sk_bf16x8 bb = *(const sk_bf16x8*)(bp[b] + k0); acc[b] = __builtin_amdgcn_mfma_f32_16x16x32_bf16(a, bb, acc[b], 0, 0, 0); }
    }
}
template <int NB> __device__ __forceinline__ void skinny16_wg(LAS unsigned char* lds, const bf16* A, int lda, const bf16* Bt, int ldb, int K, const int (&brow)[NB], f32x4 (&acc)[NB], int lane, int wave) {
    const int kper = K / 8;
    skinny16<NB>(A + wave * kper, lda, Bt + wave * kper, ldb, kper, brow, acc, lane);
    LAS f32x4* red = (LAS f32x4*)lds;
#pragma unroll
    for (int b = 0; b < NB; ++b) red[(wave * NB + b) * 64 + lane] = acc[b];
    __syncthreads();
    if (wave == 0) {
#pragma unroll
        for (int w = 1; w < 8; ++w)
#pragma unroll
            for (int b = 0; b < NB; ++b) acc[b] = acc[b] + red[(w * NB + b) * 64 + lane];
    }
    __syncthreads();
}
__device__ __forceinline__ float ss16(const float* p, int row) { float s = 0.f;
#pragma unroll
    for (int i = 0; i < 4; ++i) { const f32x4 v = *(const f32x4*)(p + (size_t)row * 16 + 4 * i); s += (v[0] + v[1]) + (v[2] + v[3]); }
    return s; }

__global__ void __launch_bounds__(NWAVES * 64, 2) fwd_kernel(Args args) {
    extern __shared__ __attribute__((aligned(16))) unsigned char lds_raw[];
    LAS unsigned char* lds = (LAS unsigned char*)lds_raw;
    const int tid = threadIdx.x, lane = tid & 63, wave = __builtin_amdgcn_readfirstlane(tid >> 6);
    const int G = gridDim.x, bx = blockIdx.x;
    volatile LAS unsigned* barst = (volatile LAS unsigned*)(lds + RING_BYTES + 64);
    if (tid < 2) barst[tid] = 0u;
    __syncthreads();
    XcdBarrier xbar; xbar.bar = (unsigned*)(args.ws + WS_BAR); xbar.x = 0; xbar.st = barst;
    unsigned char* ws = args.ws;
    const float* x = args.in[0]; const float* meta = args.in[1];
    float* out = args.out;
    float *SS0 = (float*)(ws + WS_SS0), *SS1 = (float*)(ws + WS_SS1P), *SS2 = (float*)(ws + WS_SS2P), *SSCQ = (float*)(ws + WS_SSCQ), *SSCKV = (float*)(ws + WS_SSCKV), *ROPE = (float*)(ws + WS_ROPE);
    bf16 *WGU1 = (bf16*)(ws + WS_WGU1), *WD1 = (bf16*)(ws + WS_WD1), *WGU2 = (bf16*)(ws + WS_WGU2), *WD2 = (bf16*)(ws + WS_WD2), *WIN = (bf16*)(ws + WS_WIN), *WUQ = (bf16*)(ws + WS_WUQ),
         *WUKV = (bf16*)(ws + WS_WUKV), *WBF = (bf16*)(ws + WS_WBF), *WBM = (bf16*)(ws + WS_WBM), *WOUT = (bf16*)(ws + WS_WOUT);
    bf16 *AB = (bf16*)(ws + WS_AB), *AF = (bf16*)out, *AM = (bf16*)out + (size_t)MROWS * 512,
         *HMID = (bf16*)(ws + WS_HMID), *RAW = (bf16*)(ws + WS_RAW), *QRAW = (bf16*)(ws + WS_QRAW);
    bf16 *KVRAW = (bf16*)(ws + WS_KVRAW), *KR = (bf16*)(ws + WS_KR), *MIX = (bf16*)(ws + WS_MIX), *TT = (bf16*)(ws + WS_T);
    float *LOGF = (float*)(ws + WS_LOGF);
    const int lo = args.ph_lo, hi = args.ph_hi;
#ifndef SKIP_MASK
#define SKIP_MASK 0
#endif
#define IN(k) (lo <= (k) && (k) < hi)
#define RUN(k) (IN(k) && !((SKIP_MASK >> (k)) & 1))
#ifndef REPEAT_MASK
#define REPEAT_MASK 0
#endif
#define NREP(k) (((REPEAT_MASK >> (k)) & 1) ? 2 : 1)
#define SEAM(k) do { if (IN(k) && IN((k) + 1)) { if ((k) == 0) { cg::this_grid().sync(); xbar = xcd_barrier_post((unsigned*)(args.ws + WS_BAR), barst); } else { xcd_barrier(xbar); } } } while (0)
    const int gw = bx * NWAVES + wave, NGW = G * NWAVES;
#define RS_FILL(S_, SSP_) do { LAS int* pml_ = (LAS int*)(lds + RING_BYTES + 512); LAS float* rsl_ = (LAS float*)(lds + RING_BYTES + 1024); \
        if (tid == 0) { int cnt_ = 0; pg8::Unit u_; for (int i_ = 0; (S_).next(i_, u_); ++i_) { bool seen_ = false; for (int k_ = 0; k_ < cnt_; ++k_) seen_ = seen_ || (pml_[k_] == u_.pm); \
            if (!seen_ && cnt_ < 8) pml_[cnt_++] = u_.pm; } pml_[8] = cnt_; } \
        __syncthreads(); \
        { const int cnt_ = pml_[8]; for (int idx_ = tid; idx_ < cnt_ * 256; idx_ += NWAVES * 64) { const int row_ = pml_[idx_ >> 8] * 256 + (idx_ & 255); rsl_[idx_] = rsqrtf(ss16((SSP_), row_) * (1.f / 1024.f) + EPS); } } \
        __syncthreads(); } while (0)
#define RS_TABLE(SSP_) epi::RsTable{(const LAS float*)(lds + RING_BYTES + 1024), (const LAS int*)(lds + RING_BYTES + 512), ((const LAS int*)(lds + RING_BYTES + 512))[8], (SSP_)}
    constexpr int C_FQ = 0, C_FK = 512, C_FV = 1024, C_FL = 1536, C_CQ = 1544, C_CKV = 1800, C_KR = 1928, C_GATE = 1960;

    if (RUN(0)) {
        if (bx == 0) for (int i = tid; i < XCD_BAR_WORDS; i += NWAVES * 64) ((unsigned*)(ws + WS_BAR))[i] = 0u;
        for (int i = bx * 512 + tid; i < 2064 * 16; i += G * 512) { const int pos = i >> 4, fi = i & 15;
            const float invf = __builtin_amdgcn_exp2f(-(float)fi * 0.8304820237218406f);
            const double rev = (double)((float)pos * invf) * 0.15915494309189535; const float fr = (float)(rev - floor(rev));
            ROPE[2 * i] = __builtin_amdgcn_cosf(fr); ROPE[2 * i + 1] = __builtin_amdgcn_sinf(fr); }
        LAS float* scr = (LAS float*)(lds + wave * 16384);
        constexpr int I_GU = 176 * 16, I_D = 32 * 44, I_WIN = 128 * 16, I_UQ = 24 * 4, I_UKV = 32 * 4, I_B = 32 * 8, I_OUT = 32 * 16;
        constexpr int NITEMS = 2 * I_GU + 2 * I_D + I_WIN + I_UQ + I_UKV + 2 * I_B + I_OUT;
        for (int ph = 0; ph < 2; ++ph) {
        if ((ph == 0) != ((wave & 1) != 0))
        for (int it = gw; it < NITEMS; it += NGW) {
            int r = it;
            if (r < 2 * I_GU) { const int l = r / I_GU; r -= l * I_GU; const int rb = r / 16, kb = r % 16; const int pn = rb >> 3, bj = (rb >> 2) & 1, q = rb & 3;
                tr_item(args.in[l ? 21 : 3], 5632, bj * 2816 + pn * 128 + q * 32, 32, args.in[l ? 20 : 2], l ? WGU2 : WGU1, 1024, rb * 32, kb * 64, scr, lane); continue; } r -= 2 * I_GU;
            if (r < 2 * I_D) { const int l = r / I_D; r -= l * I_D; const int rb = r / 44, kb = r % 44;
                tr_item(args.in[l ? 22 : 4], 1024, rb * 32, 32, nullptr, l ? WD2 : WD1, 2816, rb * 32, kb * 64, scr, lane); continue; } r -= 2 * I_D;
            if (r < I_WIN) { const int rb = r / 16, kb = r % 16; const int nv = (rb * 32 + 32 <= 4008) ? 32 : ((rb * 32 < 4008) ? 4008 - rb * 32 : 0);
                tr_item(args.in[6], 4008, rb * 32, nv, args.in[5], WIN, 1024, rb * 32, kb * 64, scr, lane); continue; } r -= I_WIN;
            if (r < I_UQ) { const int rb = r / 4, kb = r % 4; tr_item(args.in[12], 768, rb * 32, 32, args.in[11], WUQ, 256, rb * 32, kb * 64, scr, lane); continue; } r -= I_UQ;
            if (r < I_UKV) { const int rb = r / 4, kb = r % 4;
                tr_item(args.in[14], 1024, rb * 32, kb < 2 ? 32 : 0, args.in[13], WUKV, 256, rb * 32, kb * 64, scr, lane); continue; } r -= I_UKV;
            if (r < 2 * I_B) { const int l = r / I_B; r -= l * I_B; const int rb = r / 8, kb = r % 8;
                tr_item(args.in[l ? 18 : 17], 1024, rb * 32, 32, nullptr, l ? WBM : WBF, 512, rb * 32, kb * 64, scr, lane); continue; } r -= 2 * I_B;
            { const int rb = r / 16, kb = r % 16; tr_item(args.in[19], 1024, rb * 32, 32, nullptr, WOUT, 1024, rb * 32, kb * 64, scr, lane); }
        }
        else
        for (int m0 = 2 * gw; m0 < MROWS + NMETA; m0 += 2 * NGW) {
            f32x4 v[2][4];
#pragma unroll
            for (int q = 0; q < 2; ++q) { const int m = m0 + q; const float* src = (m < MROWS) ? x + (size_t)m * 1024 : meta + (size_t)(m - MROWS) * 1024;
#pragma unroll
                for (int j = 0; j < 4; ++j) v[q][j] = *((const f32x4*)src + lane + 64 * j); }
#pragma unroll
            for (int q = 0; q < 2; ++q) { float s = 0.f;
#pragma unroll
                for (int j = 0; j < 4; ++j) s += (v[q][j][0] * v[q][j][0] + v[q][j][1] * v[q][j][1]) + (v[q][j][2] * v[q][j][2] + v[q][j][3] * v[q][j][3]);
                s = wave_sum(s); if (lane == 0) SS0[m0 + q] = s;
                const float rs0 = rsqrtf(s * (1.f / 1024.f) + EPS);
                v2u* o8 = (v2u*)(AB + (size_t)(m0 + q) * 1024) + lane;
#pragma unroll
                for (int j = 0; j < 4; ++j) { const f32x4 t = v[q][j] * rs0; v2u o; o.x = pk2(t[0], t[1]); o.y = pk2(t[2], t[3]); o8[64 * j] = o; }
            }
        }
        }
    }
    SEAM(0);
    if (RUN(1)) {
        if (bx < 176) {
            const int pn = bx >> 3, jb = bx & 7; const int brow[2] = {256 * pn + 16 * jb, 256 * pn + 128 + 16 * jb}; f32x4 acc[2];
            skinny16_wg<2>(lds, AB + (size_t)MROWS * 1024, 1024, WGU1, 1024, 1024, brow, acc, lane, wave);
            if (wave == 0)
#pragma unroll
            for (int j = 0; j < 4; ++j) { const int row = MROWS + 4 * (lane >> 4) + j;
                const float gg = acc[0][j], uu = acc[1][j]; const float hv = gg * epi::sigm(gg) * uu;
                HMID[(size_t)row * 2816 + 128 * pn + 16 * jb + (lane & 15)] = (bf16)f2bf(hv); }
        }
        pg8::Gemm g{AB, WGU1, MROWS, 5632, 1024, 1024}; pg8::StaticOrder S; S.init(MROWS, 5632, G, bx);
        epi::EpiSwiglu<0> E{HMID, 2816, SS0, {}}; pg8::gemm_phase<epi::EpiSwiglu<0>, pg8::StaticOrder, true, true>(lds, g, S, E); }
    SEAM(1);
    if (RUN(2)) {
        if (bx < 16) {
            const int brow[4] = {64 * bx, 64 * bx + 16, 64 * bx + 32, 64 * bx + 48}; f32x4 acc[4];
            skinny16_wg<4>(lds, HMID + (size_t)MROWS * 2816, 2816, WD1, 2816, 2816, brow, acc, lane, wave);
            if (wave == 0)
#pragma unroll
            for (int j = 0; j < 4; ++j) { const int r16 = 4 * (lane >> 4) + j; float sq = 0.f;
#pragma unroll
                for (int b = 0; b < 4; ++b) { const int col = 64 * bx + 16 * b + (lane & 15); const float v = meta[(size_t)r16 * 1024 + col] + 0.5f * acc[b][j];
                    AB[(size_t)(MROWS + r16) * 1024 + col] = (bf16)f2bf(v); sq += v * v; }
                sq += __shfl_xor(sq, 1); sq += __shfl_xor(sq, 2); sq += __shfl_xor(sq, 4); sq += __shfl_xor(sq, 8);
                if ((lane & 15) == 0) SS1[(size_t)(MROWS + r16) * 16 + bx] = sq; }
        }
        pg8::Gemm g{HMID, WD1, MROWS, 1024, 2816, 2816}; pg8::StaticOrder S; S.init(MROWS, 1024, G, bx);
        epi::EpiRes<true, false, false, true, true> E{x, nullptr, nullptr, AB, SS1}; pg8::gemm_phase<epi::EpiRes<true, false, false, true, true>, pg8::StaticOrder, true, true>(lds, g, S, E); }
    SEAM(2);
    if (RUN(3)) {
        if (bx < 91) {
            const int brow[1] = {512 + 16 * bx}; f32x4 acc[1];
            skinny16_wg<1>(lds, AB + (size_t)MROWS * 1024, 1024, WIN, 1024, 1024, brow, acc, lane, wave);
            if (wave == 0)
#pragma unroll
            for (int j = 0; j < 4; ++j) { const int row = MROWS + 4 * (lane >> 4) + j; const float rs = rsqrtf(ss16(SS1, row) * (1.f / 1024.f) + EPS);
                RAW[(size_t)row * 4096 + 512 + 16 * bx + (lane & 15)] = (bf16)f2bf(acc[0][j] * rs); }
        }
        pg8::Gemm g{AB, WIN, MROWS, 4096, 1024, 1024}; pg8::StaticOrder S; S.init(MROWS, 4096, G, bx);
        RS_FILL(S, SS1);
        epi::EpiRowScale<-1> E{RAW, 4096, SS1, 1.f / 1024.f, RS_TABLE(SS1)}; pg8::gemm_phase<epi::EpiRowScale<-1>, pg8::StaticOrder, true, true>(lds, g, S, E); }
    SEAM(3);
    if (RUN(4)) {
        const float* gfq = args.in[9]; const float* gfk = args.in[10]; const float* bfor = args.in[7];
        const int hd16 = lane >> 2, sub = lane & 3;
        for (int row0 = 2 * gw; row0 < MROWS + NMETA; row0 += 2 * NGW) {
            v4u a[2], b[2]; v2u c[2]; unsigned d[2]; unsigned short fl[2];
#pragma unroll
            for (int q = 0; q < 2; ++q) { const bf16* rp = RAW + (size_t)(row0 + q) * 4096; const bf16* p = rp + hd16 * 64 + sub * 16;
                a[q] = *(const v4u*)p; b[q] = *(const v4u*)(p + 8); c[q] = *(const v2u*)(rp + C_CQ + 4 * lane); d[q] = *(const unsigned*)(rp + C_CKV + 2 * lane); fl[q] = rp[C_FL + (lane & 7)]; }
#pragma unroll
            for (int q = 0; q < 2; ++q) { const int row = row0 + q; bf16* rp = RAW + (size_t)row * 4096; bf16* p = rp + hd16 * 64 + sub * 16;
              { float v[16];
                v[0] = bflo(a[q].x); v[1] = bfhi(a[q].x); v[2] = bflo(a[q].y); v[3] = bfhi(a[q].y); v[4] = bflo(a[q].z); v[5] = bfhi(a[q].z); v[6] = bflo(a[q].w); v[7] = bfhi(a[q].w);
                v[8] = bflo(b[q].x); v[9] = bfhi(b[q].x); v[10] = bflo(b[q].y); v[11] = bfhi(b[q].y); v[12] = bflo(b[q].z); v[13] = bfhi(b[q].z); v[14] = bflo(b[q].w); v[15] = bfhi(b[q].w);
                float s = 0.f;
#pragma unroll
                for (int i = 0; i < 16; ++i) s += v[i] * v[i];
                s += __shfl_xor(s, 1); s += __shfl_xor(s, 2);
                const float* gn = (hd16 < 8 ? gfq : gfk) + sub * 16;
                const float rr = rsqrtf(s * (1.f / 64.f) + EPS) * (hd16 < 8 ? 0.125f * L2E : 1.f);
#pragma unroll
                for (int i = 0; i < 16; ++i) v[i] = v[i] * rr * gn[i];
                v4u oa, ob; oa.x = pk2(v[0], v[1]); oa.y = pk2(v[2], v[3]); oa.z = pk2(v[4], v[5]); oa.w = pk2(v[6], v[7]);
                ob.x = pk2(v[8], v[9]); ob.y = pk2(v[10], v[11]); ob.z = pk2(v[12], v[13]); ob.w = pk2(v[14], v[15]);
                *(v4u*)p = oa; *(v4u*)(p + 8) = ob; }
              if (lane < 8) { const float z = __uint_as_float((unsigned)fl[q] << 16) + bfor[lane];
                LOGF[(size_t)row * 8 + lane] = fminf(z, 0.f) - log1pf(expf(-fabsf(z))); }
              { float s1 = bflo(c[q].x) * bflo(c[q].x) + bfhi(c[q].x) * bfhi(c[q].x) + bflo(c[q].y) * bflo(c[q].y) + bfhi(c[q].y) * bfhi(c[q].y);
                float s2 = bflo(d[q]) * bflo(d[q]) + bfhi(d[q]) * bfhi(d[q]);
                s1 = wave_sum(s1); s2 = wave_sum(s2);
                if (lane == 0) { SSCQ[row] = s1; SSCKV[row] = s2; } }
            }
        }
    }
    SEAM(4);
    if (RUN(5)) {
        if (gw < 64) {
            const int brow[1] = {16 * gw}; f32x4 acc[1];
            skinny16<1>(RAW + (size_t)MROWS * 4096 + C_CKV, 4096, WUKV, 256, 128, brow, acc, lane);
#pragma unroll
            for (int j = 0; j < 4; ++j) { const int row = MROWS + 4 * (lane >> 4) + j; const float rs = rsqrtf(SSCKV[row] * (1.f / 128.f) + EPS);
                KVRAW[(size_t)row * 1024 + 16 * gw + (lane & 15)] = (bf16)f2bf(acc[0][j] * rs); }
        }
        { pg8::Gemm g{RAW + C_CQ, WUQ, MROWS, 768, 256, 4096}; pg8::StaticOrder S; S.init(MROWS, 768, G, bx);
          epi::EpiRowScale<1> E{QRAW, 768, SSCQ, 1.f / 256.f, {}}; pg8::gemm_phase<epi::EpiRowScale<1>, pg8::StaticOrder, true, true>(lds, g, S, E); }
        { pg8::Gemm g{RAW + C_CKV, WUKV, MROWS, 1024, 256, 4096}; pg8::StaticOrder S; S.init(MROWS, 1024, G, bx);
          epi::EpiRowScale<1> E{KVRAW, 1024, SSCKV, 1.f / 128.f, {}}; pg8::gemm_phase<epi::EpiRowScale<1>, pg8::StaticOrder, true, true>(lds, g, S, E); }
    }
    SEAM(5);
    if (RUN(6)) {
        const float* gqn = args.in[15]; const float* gkn = args.in[16];
        const int hd = lane >> 3, sub = lane & 7;
        const float QS = 0.10206207261596577f * L2E;
        constexpr int NTOT = 2 * MROWS + NMETA;
        for (int m0 = gw; m0 < NTOT; m0 += 2 * NGW) {
            bool isq[2], val[2]; int row[2], pos[2]; v4u a[2]; unsigned b1[2], b2[2];
#pragma unroll
            for (int q = 0; q < 2; ++q) { const int m = m0 + q * NGW; val[q] = m < NTOT; const int mm = val[q] ? m : m0;
                isq[q] = mm < MROWS; row[q] = isq[q] ? mm : mm - MROWS; pos[q] = (row[q] < MROWS) ? NMETA + (row[q] & (SEQ - 1)) : row[q] - MROWS;
                if (isq[q]) { const bf16* p = QRAW + (size_t)row[q] * 768 + hd * 96; a[q] = *(const v4u*)(p + 8 * sub); b1[q] = *(const unsigned*)(p + 64 + 2 * sub); b2[q] = *(const unsigned*)(p + 80 + 2 * sub); }
                else { const bf16* p = KVRAW + (size_t)row[q] * 1024 + hd * 128; const bf16* kr = RAW + (size_t)row[q] * 4096 + C_KR;
                    a[q] = *(const v4u*)(p + 8 * sub); b1[q] = *(const unsigned*)(kr + 2 * sub); b2[q] = *(const unsigned*)(kr + 16 + 2 * sub); } }
#pragma unroll
            for (int q = 0; q < 2; ++q) {
                float nv[8], x1[2], x2[2];
                nv[0] = bflo(a[q].x); nv[1] = bfhi(a[q].x); nv[2] = bflo(a[q].y); nv[3] = bfhi(a[q].y); nv[4] = bflo(a[q].z); nv[5] = bfhi(a[q].z); nv[6] = bflo(a[q].w); nv[7] = bfhi(a[q].w);
                x1[0] = bflo(b1[q]); x1[1] = bfhi(b1[q]); x2[0] = bflo(b2[q]); x2[1] = bfhi(b2[q]);
                float s = x1[0] * x1[0] + x1[1] * x1[1] + x2[0] * x2[0] + x2[1] * x2[1];
#pragma unroll
                for (int i = 0; i < 8; ++i) s += nv[i] * nv[i];
                s += __shfl_xor(s, 1); s += __shfl_xor(s, 2); s += __shfl_xor(s, 4);
                const float* gn = isq[q] ? gqn : gkn;
                const float rr = rsqrtf(s * (1.f / 96.f) + EPS) * (isq[q] ? QS : 1.f);
                v4u o; float t8[8];
#pragma unroll
                for (int i = 0; i < 8; ++i) t8[i] = nv[i] * rr * gn[8 * sub + i];
                o.x = pk2(t8[0], t8[1]); o.y = pk2(t8[2], t8[3]); o.z = pk2(t8[4], t8[5]); o.w = pk2(t8[6], t8[7]);
                float r1[2], r2[2];
#pragma unroll
                for (int i = 0; i < 2; ++i) { const int fi = 2 * sub + i; const float cs = ROPE[(pos[q] * 16 + fi) * 2], sn = ROPE[(pos[q] * 16 + fi) * 2 + 1];
                    const float aa = x1[i] * rr * gn[64 + fi], bb = x2[i] * rr * gn[80 + fi]; r1[i] = aa * cs - bb * sn; r2[i] = aa * sn + bb * cs; }
                if (val[q]) {
                    if (isq[q]) { bf16* p = QRAW + (size_t)row[q] * 768 + hd * 96; *(v4u*)(p + 8 * sub) = o; *(unsigned*)(p + 64 + 2 * sub) = pk2(r1[0], r1[1]); *(unsigned*)(p + 80 + 2 * sub) = pk2(r2[0], r2[1]); }
                    else { bf16* p = KVRAW + (size_t)row[q] * 1024 + hd * 128; *(v4u*)(p + 8 * sub) = o; bf16* qq = KR + (size_t)row[q] * 256 + hd * 32; *(unsigned*)(qq + 2 * sub) = pk2(r1[0], r1[1]); *(unsigned*)(qq + 16 + 2 * sub) = pk2(r2[0], r2[1]); }
                }
            }
        }
    }
    SEAM(6);
    if (RUN(7)) for (int rep = 0; rep < NREP(7); ++rep) {
        for (int u = bx; u < 256; u += G) { const int b = u >> 3, h = u & 7;
            attn::Tensors T{RAW, 4096, C_FQ + h * 64, RAW, 4096, C_FK + h * 64, C_FV + h * 64, RAW, 4096, 0, AF, 512, h * 64, LOGF, h, args.in[9], args.in[10]};
            attn::attn_bh<64, true>(lds, T, b); }
        for (int u = bx; u < 256; u += G) { const int b = u >> 3, h = u & 7;
            attn::Tensors T{QRAW, 768, h * 96, KVRAW, 1024, h * 128, h * 128 + 64, KR, 256, h * 32, AM, 512, h * 64, nullptr, 0, nullptr, nullptr};
            attn::attn_bh<96, false>(lds, T, b); }
    }
    SEAM(7);
    if (RUN(8)) {
        { pg8::Gemm g{AF, WBF, MROWS, 1024, 512, 512}; pg8::StaticOrder S; S.init(MROWS, 1024, G, bx);
          epi::EpiGate<0> E{TT, MIX, RAW, args.in[8], C_GATE}; pg8::gemm_phase<epi::EpiGate<0>, pg8::StaticOrder, true, true>(lds, g, S, E); }
        { pg8::Gemm g{AM, WBM, MROWS, 1024, 512, 512}; pg8::StaticOrder S; S.init(MROWS, 1024, G, bx);
          epi::EpiGate<1> E{TT, MIX, RAW, args.in[8] + 1024, C_GATE + 1024}; pg8::gemm_phase<epi::EpiGate<1>, pg8::StaticOrder, true, true>(lds, g, S, E); }
    }
    SEAM(8);
    if (RUN(9)) { pg8::Gemm g{MIX, WOUT, MROWS, 1024, 1024, 1024}; pg8::StaticOrder S; S.init(MROWS, 1024, G, bx);
        epi::EpiRes<false, true, false, true, true> E{nullptr, AB, nullptr, AB, SS2}; pg8::gemm_phase<epi::EpiRes<false, true, false, true, true>, pg8::StaticOrder, true, true>(lds, g, S, E); }
    SEAM(9);
    if (RUN(10)) { pg8::Gemm g{AB, WGU2, MROWS, 5632, 1024, 1024}; pg8::StaticOrder S; S.init(MROWS, 5632, G, bx);
        RS_FILL(S, SS2);
        epi::EpiSwiglu<-1> E{HMID, 2816, SS2, RS_TABLE(SS2)}; pg8::gemm_phase<epi::EpiSwiglu<-1>, pg8::StaticOrder, true, true>(lds, g, S, E); }
    SEAM(10);
    if (RUN(11)) { pg8::Gemm g{HMID, WD2, MROWS, 1024, 2816, 2816}; pg8::StaticOrder S; S.init(MROWS, 1024, G, bx);
        epi::EpiRes<true, true, true, false, false> E{nullptr, AB, out, nullptr, nullptr}; pg8::gemm_phase<epi::EpiRes<true, true, true, false, false>, pg8::StaticOrder, true, true>(lds, g, S, E); }
#if defined(DUMP_MIB)
    cg::this_grid().sync();
    { const size_t n = (size_t)MROWS * 1024; const unsigned char* src = ws + (size_t)DUMP_MIB * MiB;
      for (size_t i = (size_t)bx * 512 + tid; i < n; i += (size_t)G * 512)
          out[i] = DUMP_F32 ? ((const float*)src)[i] : __uint_as_float((unsigned)((const bf16*)src)[i] << 16); }
#endif
#undef IN
#undef SEAM
}

extern "C" void kernel_launch(void* const* d_in, const int* in_sizes, int n_in, void* d_out, int out_size, void* d_ws, size_t ws_size, hipStream_t stream) {
    static int grid = 0;
    if (grid == 0) {
        if (n_in != 23 || out_size != MROWS * 1024 || ws_size < WS_END) { fprintf(stderr, "kernel_launch: unexpected shapes (n_in %d out %d ws %zu)\n", n_in, out_size, ws_size); grid = -1; return; }
        int dev = 0, cus = 0, per_cu = 0;
        (void)hipGetDevice(&dev); (void)hipDeviceGetAttribute(&cus, hipDeviceAttributeMultiprocessorCount, dev);
        if (hipFuncSetAttribute((const void*)fwd_kernel, hipFuncAttributeMaxDynamicSharedMemorySize, LDS_BYTES) != hipSuccess) { fprintf(stderr, "kernel_launch: hipFuncSetAttribute failed\n"); grid = -1; return; }
        if (hipOccupancyMaxActiveBlocksPerMultiprocessor(&per_cu, (const void*)fwd_kernel, NWAVES * 64, LDS_BYTES) != hipSuccess || per_cu < 1) { fprintf(stderr, "kernel_launch: occupancy query says %d\n", per_cu); per_cu = 1; }
        (void)hipGetLastError();
        grid = cus > 0 ? cus : 256;
    }
    if (grid < 0) return;
    Args a{};
    for (int i = 0; i < 23; ++i) a.in[i] = (const float*)d_in[i];
    a.out = (float*)d_out; a.ws = (unsigned char*)d_ws;
#if MK_N_LAUNCHES == 1
    a.ph_lo = 0; a.ph_hi = NPHASE;
    void* kargs[] = {&a};
    hipError_t e = hipLaunchCooperativeKernel((const void*)fwd_kernel, dim3(grid), dim3(NWAVES * 64), kargs, LDS_BYTES, stream);
    if (e != hipSuccess) fprintf(stderr, "kernel_launch: cooperative launch failed: %s (grid %d)\n", hipGetErrorString(e), grid);
#else
    for (int p = 0; p < NPHASE; ++p) { a.ph_lo = p; a.ph_hi = p + 1;
        hipLaunchKernelGGL(fwd_kernel, dim3(grid), dim3(NWAVES * 64), LDS_BYTES, stream, a); }
#endif
}
```

```cpp
#include <hip/hip_runtime.h>
#include <hip/hip_cooperative_groups.h>
#include <cstdio>
#include <cstdint>
namespace cg = cooperative_groups;
#define MK_N_LAUNCHES 1
#define STOP_PHASE 12
#define SKIP_MASK 0
namespace pg8 {
#define PG8_LAS __attribute__((address_space(3)))
typedef unsigned short bf16_t;
typedef short bf16x8 __attribute__((ext_vector_type(8)));
typedef float f32x4 __attribute__((ext_vector_type(4)));
typedef unsigned u32x4 __attribute__((ext_vector_type(4)));
constexpr int BM = 256, BK = 64, HALF = 128, HTB = HALF * BK * 2  , STAGE_BYTES = 8 * HTB, NXCD = 8, WGM = 8;

__host__ __device__ __forceinline__ int lds_byte(int r, int c) { const int st = (r >> 4) * 2 + (c >> 5), rr = r & 15, cc = c & 31, ob = rr * 64 + cc * 2; return st * 1024 + (ob ^ (((ob >> 9) & 1) << 5)); }
__host__ __device__ __forceinline__ void stage_rc(int b, int& R, int& C) { const int st = b / 1024, sb = b % 1024, swz = sb ^ (((sb >> 9) & 1) << 5); R = (st >> 1) * 16 + swz / 64; C = (st & 1) * 32 + (swz % 64) / 2; }
__host__ __device__ __forceinline__ int perm32(int rho) { const int n = rho >> 4, i = rho & 15; return 8 * (i >> 2) + 4 * n + (i & 3); }

struct Unit { int pm, pn; };
struct Gemm { const bf16_t* A; const bf16_t* Bt; int M, N, K, lda; };

struct StaticOrder {
    int nM, nN, nwg, G, c;
    __host__ __device__ void init(int M, int N, int G_, int c_) { nM = M / BM; nN = N / BM; nwg = nM * nN; G = G_; c = c_; }
    __host__ __device__ bool next(int i, Unit& u) const {
        const long L = (long)i * G + c; if (L >= nwg) return false;
        int wgid = (int)L; { const int q = nwg / NXCD, r = nwg % NXCD, xcd = wgid % NXCD, off = wgid / NXCD; wgid = (xcd < r ? xcd * (q + 1) : r * (q + 1) + (xcd - r) * q) + off; }
        const int nig = WGM * nN, gid = wgid / nig, fm = gid * WGM, gsz = (nM - fm) < WGM ? (nM - fm) : WGM;
        u.pm = fm + ((wgid % nig) % gsz); u.pn = (wgid % nig) / gsz; return true;
    }
    __device__ __forceinline__ void a_ready(const Unit&) const {}
    __device__ __forceinline__ void done(const Unit&) const {}
};
__device__ __forceinline__ unsigned cvt_pk_bf16(float lo, float hi) { unsigned r; asm volatile("v_cvt_pk_bf16_f32 %0, %1, %2" : "=v"(r) : "v"(lo), "v"(hi)); return r; }
typedef float f32x2 __attribute__((ext_vector_type(2)));
template <class Epi, class Sched, bool ALIGN_EPI = false, bool SP2 = false>
__device__ __forceinline__ void gemm_phase(PG8_LAS unsigned char* lds, const Gemm g, const Sched& S, const Epi& E) {
    const int tid = threadIdx.x, wid = __builtin_amdgcn_readfirstlane(tid >> 6), lane = tid & 63, wr = wid >> 2, wc = wid & 3, fr = lane & 15, fq = lane >> 4;
    const int K = g.K, nt = K / BK;
    unsigned voffA[2], voffB[2];
#pragma unroll
    for (int i = 0; i < 2; ++i) { int R, C; stage_rc(tid * 16 + i * 8192, R, C); const int Rb = Epi::PERM ? ((R & ~31) + perm32(R & 31)) : R;
        voffA[i] = (unsigned)(R * g.lda + C) * 2u; voffB[i] = (unsigned)(Rb * K + C) * 2u; }
    const size_t kstep = (size_t)(BK * 2);
    const size_t hstep = (size_t)HALF * K * 2;
    const size_t tstep = 2 * hstep;
    const size_t hstepA = (size_t)HALF * g.lda * 2, tstepA = 2 * hstepA;
    const unsigned ldsw = (unsigned)wid * 1024u;
    const int aoff = lds_byte(wr * 64 + fr, fq * 8), boff = lds_byte(wc * 32 + fr, fq * 8);
#define PG8_SA(b, h) (((b) * 2 + (h)) * HTB)
#define PG8_SB(b, h) ((4 + (b) * 2 + (h)) * HTB)
#define PG8_STAGE(bufoff, gbase, voff) do { _Pragma("unroll") for (int _i = 0; _i < 2; ++_i) \
        __builtin_amdgcn_global_load_lds((const unsigned*)((const char*)(gbase) + (voff)[_i]), (PG8_LAS unsigned*)(lds + (bufoff) + ldsw + _i * 8192), 16, 0, 0); } while (0)
#define PG8_LDA(dst, b, h) do { _Pragma("unroll") for (int m = 0; m < 4; ++m) _Pragma("unroll") for (int k = 0; k < 2; ++k) dst[m][k] = *(const PG8_LAS bf16x8*)(lds + PG8_SA(b, h) + aoff + m * 2048 + k * 1024); } while (0)
#define PG8_LDB(dst, b, h) do { _Pragma("unroll") for (int n = 0; n < 2; ++n) _Pragma("unroll") for (int k = 0; k < 2; ++k) dst[n][k] = *(const PG8_LAS bf16x8*)(lds + PG8_SB(b, h) + boff + n * 2048 + k * 1024); } while (0)
#define PG8_MMA(ai, bj, At, Bt) do { __builtin_amdgcn_s_setprio(1); _Pragma("unroll") for (int m = 0; m < 4; ++m) _Pragma("unroll") for (int n = 0; n < 2; ++n) _Pragma("unroll") for (int k = 0; k < 2; ++k) \
        acc[ai][bj][m][n] = __builtin_amdgcn_mfma_f32_16x16x32_bf16(Bt[n][k], At[m][k], acc[ai][bj][m][n], 0, 0, 0); __builtin_amdgcn_s_setprio(0); } while (0)
#define PG8_WAIT_V(n) asm volatile("s_waitcnt vmcnt(" #n ")" ::: "memory")
#define PG8_WAIT_L(n) asm volatile("s_waitcnt lgkmcnt(" #n ")" ::: "memory")
#define PG8_BAR __builtin_amdgcn_s_barrier()
#define PG8_SCHED __builtin_amdgcn_sched_barrier(0)
    Unit cur, nxt; int ui = 0;
    if (!S.next(0, cur)) return;
    f32x4 acc[2][2][4][2];
#pragma unroll
    for (int a = 0; a < 2; ++a)
#pragma unroll
        for (int b = 0; b < 2; ++b)
#pragma unroll
            for (int m = 0; m < 4; ++m)
#pragma unroll
                for (int n = 0; n < 2; ++n) acc[a][b][m][n] = (f32x4){0.f, 0.f, 0.f, 0.f};
    bf16x8 At[4][2], B0[2][2], B1[2][2];
    const char* cA = (const char*)g.A + (size_t)cur.pm * tstepA; const char* cB = (const char*)g.Bt + (size_t)cur.pn * tstep;
    S.a_ready(cur);
    if constexpr (SP2) {
        PG8_STAGE(PG8_SB(0, 0), cB, voffB); PG8_STAGE(PG8_SB(0, 1), cB + hstep, voffB); PG8_STAGE(PG8_SA(0, 0), cA, voffA); PG8_STAGE(PG8_SA(0, 1), cA + hstepA, voffA);
        if (wr == 1) PG8_BAR;
        PG8_WAIT_V(2); PG8_BAR;
        PG8_STAGE(PG8_SB(1, 0), cB + kstep, voffB); PG8_STAGE(PG8_SA(1, 0), cA + kstep, voffA); PG8_STAGE(PG8_SB(1, 1), cB + hstep + kstep, voffB);
        PG8_WAIT_V(6); PG8_BAR;
    } else {
        PG8_STAGE(PG8_SB(0, 0), cB, voffB); PG8_STAGE(PG8_SA(0, 0), cA, voffA); PG8_STAGE(PG8_SB(0, 1), cB + hstep, voffB); PG8_STAGE(PG8_SA(0, 1), cA + hstepA, voffA);
        if (wr == 1) PG8_BAR;
        PG8_WAIT_V(4); PG8_BAR;
        PG8_STAGE(PG8_SB(1, 0), cB + kstep, voffB); PG8_STAGE(PG8_SA(1, 0), cA + kstep, voffA); PG8_STAGE(PG8_SB(1, 1), cB + hstep + kstep, voffB);
        PG8_WAIT_V(6); PG8_BAR;
    }
    for (;;) {
        const bool has_next = S.next(ui + 1, nxt);
        const char* nA = has_next ? (const char*)g.A + (size_t)nxt.pm * tstepA : cA; const char* nB = has_next ? (const char*)g.Bt + (size_t)nxt.pn * tstep : cB;
        for (int t = 0; t < nt; t += 2) {
            const bool last = (t == nt - 2);
            const char* a1 = cA + (size_t)(t + 1) * kstep;
            const char* a2 = last ? nA : cA + (size_t)(t + 2) * kstep; const char* b2 = last ? nB : cB + (size_t)(t + 2) * kstep;
            const char* a3 = a2 + kstep; const char* b3 = b2 + kstep;
            if (last && has_next) S.a_ready(nxt);
            if constexpr (SP2) {
            PG8_LDB(B0, 0, 0); PG8_LDB(B1, 0, 1); PG8_SCHED; PG8_LDA(At, 0, 0); PG8_STAGE(PG8_SA(1, 1), a1 + hstepA, voffA);
            PG8_WAIT_V(8); PG8_WAIT_L(0); PG8_BAR; PG8_MMA(0, 0, At, B0); PG8_MMA(0, 1, At, B1); PG8_BAR; PG8_SCHED;
            PG8_LDA(At, 0, 1); PG8_STAGE(PG8_SB(0, 0), b2, voffB); PG8_STAGE(PG8_SB(0, 1), b2 + hstep, voffB); PG8_STAGE(PG8_SA(0, 0), a2, voffA);
            PG8_WAIT_V(8); PG8_WAIT_L(0); PG8_BAR; PG8_MMA(1, 0, At, B0); PG8_MMA(1, 1, At, B1); PG8_BAR; PG8_SCHED;
            PG8_LDB(B0, 1, 0); PG8_LDB(B1, 1, 1); PG8_SCHED; PG8_LDA(At, 1, 0); PG8_STAGE(PG8_SA(0, 1), a2 + hstepA, voffA);
            PG8_WAIT_V(8); PG8_WAIT_L(0); PG8_BAR; PG8_MMA(0, 0, At, B0); PG8_MMA(0, 1, At, B1); PG8_BAR; PG8_SCHED;
            PG8_LDA(At, 1, 1); PG8_STAGE(PG8_SB(1, 0), b3, voffB); PG8_STAGE(PG8_SB(1, 1), b3 + hstep, voffB); PG8_STAGE(PG8_SA(1, 0), a3, voffA);
            PG8_WAIT_V(8); PG8_WAIT_L(0); PG8_BAR; PG8_MMA(1, 0, At, B0); PG8_MMA(1, 1, At, B1); PG8_BAR; PG8_SCHED;
            } else {
            PG8_LDB(B0, 0, 0); PG8_SCHED; PG8_LDA(At, 0, 0); PG8_STAGE(PG8_SA(1, 1), a1 + hstepA, voffA);
            PG8_WAIT_L(8); PG8_BAR; PG8_WAIT_L(0); PG8_MMA(0, 0, At, B0); PG8_BAR; PG8_SCHED;
            PG8_LDB(B1, 0, 1); PG8_STAGE(PG8_SB(0, 0), b2, voffB);
            PG8_BAR; PG8_WAIT_L(0); PG8_MMA(0, 1, At, B1); PG8_BAR;
            PG8_LDA(At, 0, 1); PG8_STAGE(PG8_SA(0, 0), a2, voffA);
            PG8_BAR; PG8_WAIT_L(0); PG8_MMA(1, 0, At, B0); PG8_BAR; PG8_SCHED;
            PG8_STAGE(PG8_SB(0, 1), b2 + hstep, voffB);
            PG8_WAIT_V(6); PG8_BAR; PG8_MMA(1, 1, At, B1); PG8_BAR;
            PG8_LDB(B0, 1, 0); PG8_SCHED; PG8_LDA(At, 1, 0); PG8_STAGE(PG8_SA(0, 1), a2 + hstepA, voffA);
            PG8_WAIT_L(8); PG8_BAR; PG8_WAIT_L(0); PG8_MMA(0, 0, At, B0); PG8_BAR; PG8_SCHED;
            PG8_LDB(B1, 1, 1); PG8_STAGE(PG8_SB(1, 0), b3, voffB);
            PG8_BAR; PG8_WAIT_L(0); PG8_MMA(0, 1, At, B1); PG8_BAR;
            PG8_LDA(At, 1, 1); PG8_STAGE(PG8_SA(1, 0), a3, voffA);
            PG8_BAR; PG8_WAIT_L(0); PG8_MMA(1, 0, At, B0); PG8_BAR; PG8_SCHED;
            PG8_STAGE(PG8_SB(1, 1), b3 + hstep, voffB);
            PG8_WAIT_V(6); PG8_BAR; PG8_MMA(1, 1, At, B1); PG8_BAR;
            }
        }
        if constexpr (ALIGN_EPI) { if (wr == 0) PG8_BAR; }
        if constexpr (!Epi::AFTER_DRAIN) { E(acc, cur, wr, wc, fr, fq); S.done(cur); }
        if (!has_next) break;
#pragma unroll
        for (int a = 0; a < 2; ++a)
#pragma unroll
            for (int b = 0; b < 2; ++b)
#pragma unroll
                for (int m = 0; m < 4; ++m)
#pragma unroll
                    for (int n = 0; n < 2; ++n) acc[a][b][m][n] = (f32x4){0.f, 0.f, 0.f, 0.f};
        cur = nxt; cA = nA; cB = nB; ++ui;
        if constexpr (ALIGN_EPI) { if (wr == 1) PG8_BAR; }
    }
    PG8_WAIT_V(0);
    if constexpr (!ALIGN_EPI) { if (wr == 0) PG8_BAR; }
    PG8_BAR;
    if constexpr (Epi::AFTER_DRAIN) { E.fused(acc, cur, wr, wc, fr, fq, lds, wid, lane); S.done(cur); }
#undef PG8_SA
#undef PG8_SB
#undef PG8_STAGE
#undef PG8_LDA
#undef PG8_LDB
#undef PG8_MMA
#undef PG8_WAIT_V
#undef PG8_WAIT_L
#undef PG8_BAR
#undef PG8_SCHED
}
}

constexpr int MROWS = 65536;
constexpr int MROWS1 = 65792;
constexpr int NMETA = 16, SEQ = 2048, DMODEL = 1024, DFF = 2816;
constexpr float EPS = 1e-6f;
constexpr float L2E = 1.4426950408889634f;

namespace epi {
using pg8::f32x4; using pg8::u32x4; using pg8::bf16_t; using pg8::Unit; using pg8::cvt_pk_bf16;
__device__ __forceinline__ u32x4 pack8(const f32x4 a, const f32x4 b) { u32x4 w; w.x = cvt_pk_bf16(a[0], a[1]); w.y = cvt_pk_bf16(a[2], a[3]); w.z = cvt_pk_bf16(b[0], b[1]); w.w = cvt_pk_bf16(b[2], b[3]); return w; }
__device__ __forceinline__ float sq4(const f32x4 a) { return (a[0] * a[0] + a[1] * a[1]) + (a[2] * a[2] + a[3] * a[3]); }
__device__ __forceinline__ float red_fq(float s) { s += __shfl_xor(s, 16); s += __shfl_xor(s, 32); return s; }
__device__ __forceinline__ float sigm(float z) { return __builtin_amdgcn_rcpf(1.f + __builtin_amdgcn_exp2f(-z * L2E)); }
__device__ __forceinline__ f32x4 bf4_to_f32(unsigned lo, unsigned hi) { f32x4 r; r[0] = __uint_as_float(lo << 16); r[1] = __uint_as_float(lo & 0xffff0000u); r[2] = __uint_as_float(hi << 16); r[3] = __uint_as_float(hi & 0xffff0000u); return r; }

template <int NP> __device__ __forceinline__ float ss_sum(const float* p, int row) {
    if (NP == 1) return p[row];
    float s = 0.f;
#pragma unroll
    for (int i = 0; i < NP / 4; ++i) { const f32x4 v = *(const f32x4*)(p + (size_t)row * NP + 4 * i); s += (v[0] + v[1]) + (v[2] + v[3]); }
    return s;
}

#define EPI_LAS __attribute__((address_space(3)))
struct RsTable { const EPI_LAS float* rs; const EPI_LAS int* pm; int cnt; const float* ssp; };
__device__ __forceinline__ float rs_lookup(const RsTable& t, int pm, int rin, int row) {
    int slot = -1;
    for (int k = 0; k < t.cnt; ++k) if (t.pm[k] == pm) slot = k;
    if (slot >= 0) return t.rs[slot * 256 + rin];
    return rsqrtf(ss_sum<16>(t.ssp, row) * (1.f / 1024.f) + EPS);
}

template <int NP> struct EpiSwiglu {
    static constexpr bool PERM = true, AFTER_DRAIN = false;
    bf16_t* O; int ldo; const float* ss; RsTable tab;
    __device__ __forceinline__ void operator()(const f32x4 (&acc)[2][2][4][2], const Unit& u, int wr, int wc, int fr, int fq) const {
        const int ocol = u.pn * 128 + wc * 32 + 8 * fq;
#pragma unroll
        for (int ai = 0; ai < 2; ++ai)
#pragma unroll
            for (int m = 0; m < 4; ++m) {
                const int row = u.pm * 256 + ai * 128 + wr * 64 + m * 16 + fr;
                const float rs = (NP == 0) ? 1.f : (NP < 0 ? rs_lookup(tab, u.pm, ai * 128 + wr * 64 + m * 16 + fr, row) : rsqrtf(ss_sum<(NP <= 0 ? 1 : NP)>(ss, row) * (1.f / 1024.f) + EPS));
                f32x4 h[2];
#pragma unroll
                for (int n = 0; n < 2; ++n) { const f32x4 g = acc[ai][0][m][n] * rs, up = acc[ai][1][m][n] * rs;
#pragma unroll
                    for (int i = 0; i < 4; ++i) h[n][i] = g[i] * sigm(g[i]) * up[i]; }
                *(u32x4*)(O + (size_t)row * ldo + ocol) = pack8(h[0], h[1]);
            }
    }
};

template <bool HALF, bool RESB, bool OUTF, bool HASB, bool HASSS> struct EpiRes {
    static constexpr bool PERM = true, AFTER_DRAIN = false;
    const float* resf; const bf16_t* resb; float* outf; bf16_t* outb; float* ss;
    __device__ __forceinline__ void operator()(const f32x4 (&acc)[2][2][4][2], const Unit& u, int wr, int wc, int fr, int fq) const {
        const float coef = HALF ? 0.5f : 1.0f;
#pragma unroll
        for (int ai = 0; ai < 2; ++ai)
#pragma unroll
            for (int m = 0; m < 4; ++m) {
                const int row = u.pm * 256 + ai * 128 + wr * 64 + m * 16 + fr;
                float sq = 0.f;
#pragma unroll
                for (int bj = 0; bj < 2; ++bj) {
                    const size_t off = (size_t)row * 1024 + u.pn * 256 + bj * 128 + wc * 32 + 8 * fq;
                    f32x4 r0, r1;
                    if (RESB) { const u32x4 w = *(const u32x4*)(resb + off); r0 = bf4_to_f32(w.x, w.y); r1 = bf4_to_f32(w.z, w.w); }
                    else { r0 = *(const f32x4*)(resf + off); r1 = *(const f32x4*)(resf + off + 4); }
                    const f32x4 v0 = r0 + acc[ai][bj][m][0] * coef, v1 = r1 + acc[ai][bj][m][1] * coef;
                    if (OUTF) { __builtin_nontemporal_store(v0, (f32x4*)(outf + off)); __builtin_nontemporal_store(v1, (f32x4*)(outf + off + 4)); }
                    if (HASB) *(u32x4*)(outb + off) = pack8(v0, v1);
                    sq += sq4(v0) + sq4(v1);
                }
                if (HASSS) { sq = red_fq(sq); if (fq == 0) ss[(size_t)row * 16 + u.pn * 4 + wc] = sq; }
            }
    }
};

template <int NP> struct EpiRowScale {
    static constexpr bool PERM = true, AFTER_DRAIN = false;
    bf16_t* O; int ldo; const float* ss; float invn; RsTable tab;
    __device__ __forceinline__ void operator()(const f32x4 (&acc)[2][2][4][2], const Unit& u, int wr, int wc, int fr, int fq) const {
#pragma unroll
        for (int ai = 0; ai < 2; ++ai)
#pragma unroll
            for (int m = 0; m < 4; ++m) {
                const int row = u.pm * 256 + ai * 128 + wr * 64 + m * 16 + fr;
                const float rs = NP < 0 ? rs_lookup(tab, u.pm, ai * 128 + wr * 64 + m * 16 + fr, row) : rsqrtf(ss_sum<(NP <= 0 ? 1 : NP)>(ss, row) * invn + EPS);
#pragma unroll
                for (int bj = 0; bj < 2; ++bj) {
                    const int col = u.pn * 256 + bj * 128 + wc * 32 + 8 * fq;
                    *(u32x4*)(O + (size_t)row * ldo + col) = pack8(acc[ai][bj][m][0] * rs, acc[ai][bj][m][1] * rs);
                }
            }
    }
};

template <int MODE> struct EpiGate {
    static constexpr bool PERM = true, AFTER_DRAIN = false;
    bf16_t* T; bf16_t* MIX; const bf16_t* raw; const float* bias; int goff;
    __device__ __forceinline__ void operator()(const f32x4 (&acc)[2][2][4][2], const Unit& u, int wr, int wc, int fr, int fq) const {
        f32x4 bg[2][2];
#pragma unroll
        for (int bj = 0; bj < 2; ++bj)
#pragma unroll
            for (int n = 0; n < 2; ++n) bg[bj][n] = *(const f32x4*)(bias + u.pn * 256 + bj * 128 + wc * 32 + 8 * fq + 4 * n);
#pragma unroll
        for (int ai = 0; ai < 2; ++ai)
#pragma unroll
            for (int m = 0; m < 4; ++m) {
                const int row = u.pm * 256 + ai * 128 + wr * 64 + m * 16 + fr;
#pragma unroll
                for (int bj = 0; bj < 2; ++bj) {
                    const int col = u.pn * 256 + bj * 128 + wc * 32 + 8 * fq;
                    const u32x4 gw = *(const u32x4*)(raw + (size_t)row * 4096 + goff + col);
                    f32x4 g0 = bf4_to_f32(gw.x, gw.y) + bg[bj][0], g1 = bf4_to_f32(gw.z, gw.w) + bg[bj][1];
#pragma unroll
                    for (int i = 0; i < 4; ++i) { g0[i] = sigm(g0[i]); g1[i] = sigm(g1[i]); }
                    f32x4 v0 = acc[ai][bj][m][0] * g0, v1 = acc[ai][bj][m][1] * g1;
                    bf16_t* tp = T + (size_t)row * 1024 + col;
                    if (MODE == 0) { *(u32x4*)tp = pack8(v0, v1); }
                    else { const u32x4 tw = *(const u32x4*)tp; v0 = v0 + bf4_to_f32(tw.x, tw.y); v1 = v1 + bf4_to_f32(tw.z, tw.w); *(u32x4*)(MIX + (size_t)row * 1024 + col) = pack8(v0, v1); }
                }
            }
    }
};
}

namespace attn {
#define ALAS __attribute__((address_space(3)))
typedef unsigned short bf16_t;
typedef short bf16x8 __attribute__((ext_vector_type(8)));
typedef short s16x4 __attribute__((ext_vector_type(4)));
typedef float f32x16 __attribute__((ext_vector_type(16)));
typedef float f32x4 __attribute__((ext_vector_type(4)));
typedef unsigned u32x4 __attribute__((ext_vector_type(4)));
typedef unsigned u32x2 __attribute__((ext_vector_type(2)));
typedef float f32x2_t __attribute__((ext_vector_type(2))); typedef __bf16 bf16x2_t __attribute__((ext_vector_type(2)));
__device__ __forceinline__ unsigned cvtpk(float lo, float hi) { f32x2_t v = {lo, hi}; bf16x2_t b = __builtin_convertvector(v, bf16x2_t); return __builtin_bit_cast(unsigned, b); }
__device__ __forceinline__ s16x4 vtr(const ALAS unsigned char* p) { return __builtin_bit_cast(s16x4, __builtin_amdgcn_ds_read_tr16_b64_v4i16((ALAS s16x4*)p)); }
constexpr float NEGBIG = -1e30f;
constexpr int VP = 144;


struct Tensors {
    const bf16_t* Q; int ldq, qoff;
    const bf16_t* KV; int ldkv, k1off, voff;
    const bf16_t* K2; int ldk2, k2off;
    bf16_t* O; int ldo, ooff;
    const float* logf;
    int hcol;
    const float* gq; const float* gk;
};

__device__ __forceinline__ float pl32max(float m) { auto rr = __builtin_amdgcn_permlane32_swap(__float_as_uint(m), __float_as_uint(m), false, false); return fmaxf(__uint_as_float(rr[0]), __uint_as_float(rr[1])); }
__device__ __forceinline__ float pl32sum(float m) { auto rr = __builtin_amdgcn_permlane32_swap(__float_as_uint(m), __float_as_uint(m), false, false); return __uint_as_float(rr[0]) + __uint_as_float(rr[1]); }

template <int DK, int NH, bool MASK, bool BIAS>
__device__ __forceinline__ void attn_qk(f32x16 (&x)[NH], const ALAS unsigned char* kbase, const ALAS float* tbp, const bf16x8 (&qf)[DK / 16], int r, int h, int kfirst, int qg) {
    constexpr int KP = DK * 2 + 16, NS = DK / 16;
#pragma unroll
    for (int hh = 0; hh < NH; ++hh) {
        if (BIAS) {
#pragma unroll
            for (int g = 0; g < 4; ++g) { const f32x4 a = *(const ALAS f32x4*)(tbp + 32 * hh + 4 * h + 8 * g);
                x[hh][4 * g] = a[0]; x[hh][4 * g + 1] = a[1]; x[hh][4 * g + 2] = a[2]; x[hh][4 * g + 3] = a[3]; }
        } else {
#pragma unroll
            for (int i = 0; i < 16; ++i) x[hh][i] = 0.f;
        }
    }
    { const ALAS unsigned char* kb = kbase + r * KP + h * 16;
      bf16x8 kf[2][NH];
#pragma unroll
      for (int hh = 0; hh < NH; ++hh) kf[0][hh] = *(const ALAS bf16x8*)(kb + hh * 32 * KP);
#pragma unroll
      for (int s = 0; s < NS; ++s) {
          if (s + 1 < NS) {
#pragma unroll
              for (int hh = 0; hh < NH; ++hh) kf[(s + 1) & 1][hh] = *(const ALAS bf16x8*)(kb + hh * 32 * KP + (s + 1) * 32);
          }
#pragma unroll
          for (int hh = 0; hh < NH; ++hh) x[hh] = __builtin_amdgcn_mfma_f32_32x32x16_bf16(kf[s & 1][hh], qf[s], x[hh], 0, 0, 0);
          __builtin_amdgcn_sched_barrier(0);
      } }
    if (MASK) {
#pragma unroll
        for (int hh = 0; hh < NH; ++hh)
#pragma unroll
            for (int i = 0; i < 16; ++i) { const int kv = kfirst + 32 * hh + 4 * h + (i & 3) + 8 * (i >> 2); if (kv > qg) x[hh][i] = NEGBIG; }
    }
}
template <int NH>
__device__ __forceinline__ void attn_pv(f32x16 (&x)[NH], const ALAS unsigned char* vbase, float& lrun, f32x16& o0, f32x16& o1, int h, int q4, int p4, int blk) {
    f32x2_t ps0 = {0.f, 0.f}, ps1 = {0.f, 0.f};
#pragma unroll
    for (int hh = 0; hh < NH; ++hh)
#pragma unroll
        for (int i = 0; i < 16; i += 4) {
            x[hh][i] = __builtin_amdgcn_exp2f(x[hh][i]); x[hh][i + 1] = __builtin_amdgcn_exp2f(x[hh][i + 1]);
            x[hh][i + 2] = __builtin_amdgcn_exp2f(x[hh][i + 2]); x[hh][i + 3] = __builtin_amdgcn_exp2f(x[hh][i + 3]);
            ps0 += (f32x2_t){x[hh][i], x[hh][i + 1]}; ps1 += (f32x2_t){x[hh][i + 2], x[hh][i + 3]}; }
    lrun += (ps0[0] + ps0[1]) + (ps1[0] + ps1[1]);
    const ALAS unsigned char* vb = vbase + (4 * h + q4) * VP + (16 * blk + 4 * p4) * 2;
    s16x4 vl[2][2];
#pragma unroll
    for (int dh = 0; dh < 2; ++dh) { vl[dh][0] = vtr(vb + dh * 64); vl[dh][1] = vtr(vb + 8 * VP + dh * 64); }
#pragma unroll
    for (int st = 0; st < 2 * NH; ++st) {
        const int hh = st >> 1, s2 = st & 1;
        u32x4 pw;
#pragma unroll
        for (int j = 0; j < 4; ++j) pw[j] = cvtpk(x[hh][8 * s2 + 2 * j], x[hh][8 * s2 + 2 * j + 1]);
        const bf16x8 pf = __builtin_bit_cast(bf16x8, pw);
        const bf16x8 vf0 = __builtin_shufflevector(vl[0][0], vl[0][1], 0, 1, 2, 3, 4, 5, 6, 7);
        const bf16x8 vf1 = __builtin_shufflevector(vl[1][0], vl[1][1], 0, 1, 2, 3, 4, 5, 6, 7);
        o0 = __builtin_amdgcn_mfma_f32_32x32x16_bf16(vf0, pf, o0, 0, 0, 0);
        o1 = __builtin_amdgcn_mfma_f32_32x32x16_bf16(vf1, pf, o1, 0, 0, 0);
        if (st + 1 < 2 * NH) {
#pragma unroll
            for (int dh = 0; dh < 2; ++dh) { vl[dh][0] = vtr(vb + (16 * (st + 1)) * VP + dh * 64); vl[dh][1] = vtr(vb + (16 * (st + 1) + 8) * VP + dh * 64); }
        }
        __builtin_amdgcn_sched_barrier(0);
    }
}

template <int DK, int NH, bool MASK, bool BIAS>
__device__ __forceinline__ void attn_step(const ALAS unsigned char* kbase, const ALAS unsigned char* vbase, const ALAS float* tbp, const bf16x8 (&qf)[DK / 16],
                                          float& mrun, float& lrun, f32x16& o0, f32x16& o1, int r, int h, int q4, int p4, int blk, int kfirst, int qg) {
    f32x16 x[NH]; attn_qk<DK, NH, MASK, BIAS>(x, kbase, tbp, qf, r, h, kfirst, qg); attn_pv<NH>(x, vbase, lrun, o0, o1, h, q4, p4, blk);
}

constexpr int A2_KS = 0, A2_VS = 2 * 128 * 208, A2_CUM = A2_VS + 2 * 128 * VP, A2_TB = A2_CUM + 2080 * 4, A2_SC = A2_TB + 2112 * 4, A2_MK = A2_SC + 64, A2_MV = A2_MK + 32 * 208, ATTN2_LDS = A2_MV + 32 * VP;

template <int DK, bool DECAY>
__device__ __forceinline__ void attn_bh(ALAS unsigned char* lds, const Tensors& T, int b) {
    constexpr int KP = DK * 2 + 16, NS = DK / 16;
    const int tid = threadIdx.x, lane = tid & 63, r = lane & 31, h = lane >> 5;
    const int w = __builtin_amdgcn_readfirstlane(tid >> 6);
    ALAS float* cum = (ALAS float*)(lds + A2_CUM);
    ALAS float* tb = (ALAS float*)(lds + A2_TB);
    ALAS float* sc = (ALAS float*)(lds + A2_SC);
    const size_t rowbase = (size_t)b * SEQ;
    if (DECAY) {
        float v[4];
#pragma unroll
        for (int i = 0; i < 4; ++i) v[i] = T.logf[(rowbase + 4 * tid + i) * 8 + T.hcol];
        v[1] += v[0]; v[2] += v[1]; v[3] += v[2];
        float s = v[3];
#pragma unroll
        for (int o = 1; o < 64; o <<= 1) { const float n = __shfl_up(s, o); if (lane >= o) s += n; }
        if (lane == 63) sc[w] = s;
        __syncthreads();
        float base = s - v[3];
        for (int i = 0; i < w; ++i) base += sc[i];
#pragma unroll
        for (int i = 0; i < 4; ++i) cum[NMETA + 4 * tid + i] = base + v[i];
        if (tid < NMETA) { float a = 0.f; for (int j = tid + 1; j < NMETA; ++j) a += T.logf[((size_t)MROWS + j) * 8 + T.hcol]; cum[tid] = -a; }
        __syncthreads();
    }
    float TSKIP = 3.0e38f;
    if (DECAY) { float a = 0.f, c = 0.f; for (int i = 0; i < 64; ++i) { a = fmaxf(a, fabsf(T.gq[i])); c = fmaxf(c, fabsf(T.gk[i])); }
        const float QB = 8.f * a * c * L2E * 1.01f; TSKIP = (37.f + 2.f * QB) * 0.6931471805599453f; }
    const int q4 = (lane & 15) >> 2, p4 = lane & 3, blk = (lane >> 4) & 1;
    const int vr0 = tid >> 3, vc = tid & 7, k2r = tid >> 2, k2c = tid & 3;
    const unsigned kvo = (unsigned)(vr0 * T.ldkv + 8 * vc) * 2u, k2o = (unsigned)(k2r * T.ldk2 + 8 * k2c) * 2u;
    const char* kvb = (const char*)T.KV; const char* k2b = (const char*)T.K2;
    for (int qb = 7; qb >= 0; --qb) {
        const int q0 = qb * 256, NST = 2 * qb + 2;
        int st_min = 0; bool skip_meta = false, skip_h0 = false;
        if (DECAY) { const float cq0 = cum[NMETA + q0]; while (st_min < NST - 2 && cum[NMETA + 128 * st_min + 127] - cq0 >= TSKIP) ++st_min; skip_meta = (-cq0 >= TSKIP); skip_h0 = (cum[NMETA + 128 * st_min + 63] - cq0 >= TSKIP); }
        unsigned kvo_ = kvo, k2o_ = k2o; int rq_ = r; asm volatile("" : "+v"(kvo_), "+v"(k2o_), "+v"(rq_));
        { const float cref = DECAY ? cum[NMETA + q0 + 128] : 0.f;
          for (int idx = tid; idx < 32 + 128 * NST; idx += 512) { float val;
              if (idx < 32) val = (idx < NMETA) ? (DECAY ? (cref - cum[idx]) * L2E : 0.f) : NEGBIG;
              else val = DECAY ? (cref - cum[NMETA + idx - 32]) * L2E : 0.f;
              tb[idx] = val; } }
        bf16x8 qf[NS];
        { const bf16_t* qp = T.Q + (rowbase + q0 + 32 * w + rq_) * T.ldq + T.qoff + 8 * h;
#pragma unroll
          for (int s = 0; s < NS; ++s) qf[s] = *(const bf16x8*)(qp + 16 * s); }
        u32x4 kreg[2], k2reg = (u32x4){0u, 0u, 0u, 0u}, vreg[2];
#define AT_KVB(row_, off_) (kvb + ((size_t)(row_) * T.ldkv + (off_)) * 2)
#define AT_GLOAD_K(st_) do { _Pragma("unroll") for (int i_ = 0; i_ < 2; ++i_) kreg[i_] = *(const u32x4*)(AT_KVB(rowbase + 128 * (st_) + 64 * i_, T.k1off) + kvo_); \
            if (DK == 96) k2reg = *(const u32x4*)(k2b + ((size_t)(rowbase + 128 * (st_)) * T.ldk2 + T.k2off) * 2 + k2o_); } while (0)
#define AT_GLOAD_V(st_) do { _Pragma("unroll") for (int i_ = 0; i_ < 2; ++i_) vreg[i_] = *(const u32x4*)(AT_KVB(rowbase + 128 * (st_) + 64 * i_, T.voff) + kvo_); } while (0)
#define AT_LSTORE_K(buf_) do { _Pragma("unroll") for (int i_ = 0; i_ < 2; ++i_) *(ALAS u32x4*)(lds + A2_KS + (buf_) * 128 * KP + (vr0 + 64 * i_) * KP + vc * 16) = kreg[i_]; \
            if (DK == 96) *(ALAS u32x4*)(lds + A2_KS + (buf_) * 128 * KP + k2r * KP + 128 + k2c * 16) = k2reg; } while (0)
#define AT_LSTORE_V(buf_) do { _Pragma("unroll") for (int i_ = 0; i_ < 2; ++i_) *(ALAS u32x4*)(lds + A2_VS + (buf_) * 128 * VP + (vr0 + 64 * i_) * VP + vc * 16) = vreg[i_]; } while (0)
        { const u32x4 z = (u32x4){0u, 0u, 0u, 0u};
          if (tid < 256) { u32x4 kv = z, vv = z; if (vr0 < NMETA) { kv = *(const u32x4*)(AT_KVB((size_t)MROWS, T.k1off) + kvo_); vv = *(const u32x4*)(AT_KVB((size_t)MROWS, T.voff) + kvo_); }
              *(ALAS u32x4*)(lds + A2_MK + vr0 * KP + vc * 16) = kv; *(ALAS u32x4*)(lds + A2_MV + vr0 * VP + vc * 16) = vv; }
          if (DK == 96 && tid < 128) { u32x4 kv = z; if (k2r < NMETA) kv = *(const u32x4*)(k2b + ((size_t)MROWS * T.ldk2 + T.k2off) * 2 + k2o_);
              *(ALAS u32x4*)(lds + A2_MK + k2r * KP + 128 + k2c * 16) = kv; } }
        AT_GLOAD_K(st_min); AT_GLOAD_V(st_min);
        __syncthreads();
        float mrun = NEGBIG, lrun = 0.f;
        f32x16 o0, o1;
#pragma unroll
        for (int i = 0; i < 16; ++i) { o0[i] = 0.f; o1[i] = 0.f; }
        const int qg = q0 + 32 * w + r;
        if (!skip_meta) attn_step<DK, 1, false, true>(lds + A2_MK, lds + A2_MV, tb, qf, mrun, lrun, o0, o1, r, h, q4, p4, blk, 0, qg);
        if (st_min & 1) { AT_LSTORE_K(0); AT_LSTORE_V(0); } else { AT_LSTORE_K(1); AT_LSTORE_V(1); }
        if (st_min + 1 < NST) { AT_GLOAD_K(st_min + 1); AT_GLOAD_V(st_min + 1); }
        __syncthreads();
        for (int st = st_min; st < NST; ++st) {
            const int buf = (st + 1) & 1;
            const bool more = st + 1 < NST, more2 = st + 2 < NST;
            const int kt0 = 128 * st;
            if (more) AT_LSTORE_K(st & 1);
            if (more2) AT_GLOAD_K(st + 2);
            {
                const ALAS unsigned char* kb = lds + A2_KS + buf * 128 * KP; const ALAS unsigned char* vb = lds + A2_VS + buf * 128 * VP;
                const int wq0 = q0 + 32 * w;
                const bool act0 = kt0 <= wq0 + 31 && !(skip_h0 && st == st_min), act1 = kt0 + 64 <= wq0 + 31;
                f32x16 xa[2], xb[2];
                if (act0) { if (kt0 + 63 > wq0) attn_qk<DK, 2, true, DECAY>(xa, kb, tb + 32 + kt0, qf, r, h, kt0, qg); else attn_qk<DK, 2, false, DECAY>(xa, kb, tb + 32 + kt0, qf, r, h, kt0, qg); }
                if (act1) { if (kt0 + 127 > wq0) attn_qk<DK, 2, true, DECAY>(xb, kb + 64 * KP, tb + 96 + kt0, qf, r, h, kt0 + 64, qg); else attn_qk<DK, 2, false, DECAY>(xb, kb + 64 * KP, tb + 96 + kt0, qf, r, h, kt0 + 64, qg); }
                __builtin_amdgcn_sched_barrier(0);
                if (more) AT_LSTORE_V(st & 1); if (more2) AT_GLOAD_V(st + 2);
                if (act0) attn_pv<2>(xa, vb, lrun, o0, o1, h, q4, p4, blk);
                if (act1) attn_pv<2>(xb, vb + 64 * VP, lrun, o0, o1, h, q4, p4, blk);
            }
            __syncthreads();
        }
        lrun = pl32sum(lrun);
        const float inv = 1.f / lrun;
        bf16_t* op = T.O + (rowbase + q0 + 32 * w + rq_) * T.ldo + T.ooff + 4 * h;
#pragma unroll
        for (int g = 0; g < 4; ++g) {
            u32x2 a, c;
            a.x = cvtpk(o0[4 * g] * inv, o0[4 * g + 1] * inv); a.y = cvtpk(o0[4 * g + 2] * inv, o0[4 * g + 3] * inv);
            c.x = cvtpk(o1[4 * g] * inv, o1[4 * g + 1] * inv); c.y = cvtpk(o1[4 * g + 2] * inv, o1[4 * g + 3] * inv);
            *(u32x2*)(op + 8 * g) = a; *(u32x2*)(op + 32 + 8 * g) = c;
        }
    }
    __syncthreads();
}
#undef AT_KVB
#undef AT_GLOAD_K
#undef AT_GLOAD_V
#undef AT_LSTORE_K
#undef AT_LSTORE_V
}

#define LAS __attribute__((address_space(3)))
typedef unsigned short bf16;
typedef unsigned v4u __attribute__((ext_vector_type(4)));
typedef unsigned v2u __attribute__((ext_vector_type(2)));
typedef float f32x4 __attribute__((ext_vector_type(4)));
constexpr int NWAVES = 8;
constexpr int LDS_BYTES = 147456;
constexpr int RING_BYTES = 131072;
static_assert(attn::ATTN2_LDS <= RING_BYTES, "attention LDS");
#ifndef MK_N_LAUNCHES
#define MK_N_LAUNCHES 1
#endif
#ifndef STOP_PHASE
#define STOP_PHASE 12
#endif
constexpr int NPHASE = STOP_PHASE;


constexpr size_t MiB = 1u << 20;
constexpr size_t WS_SS0 = 0, WS_SSCQ = MiB / 2, WS_SSCKV = MiB, WS_BAR = 2 * MiB, WS_ROPE = 3 * MiB;
constexpr size_t WS_WGU1 = 4 * MiB, WS_WD1 = 15 * MiB, WS_WGU2 = 21 * MiB, WS_WD2 = 32 * MiB, WS_WIN = 38 * MiB, WS_WUQ = 46 * MiB, WS_WUKV = 47 * MiB,
                 WS_WBF = 48 * MiB, WS_WBM = 49 * MiB, WS_WOUT = 50 * MiB;
constexpr size_t WS_AB = 52 * MiB;
constexpr size_t WS_AF = 52 * MiB, WS_AM = 116 * MiB;
constexpr size_t WS_HMID = 181 * MiB;
constexpr size_t WS_RAW = 181 * MiB;
constexpr size_t WS_QRAW = 695 * MiB, WS_KVRAW = 791 * MiB, WS_KR = 920 * MiB, WS_LOGF = 953 * MiB, WS_SS1P = 956 * MiB, WS_SS2P = 961 * MiB, WS_END = 966 * MiB;
constexpr size_t WS_T = 695 * MiB, WS_MIX = 823 * MiB;
static_assert(WS_AB + (size_t)MROWS1 * 1024 * 2 <= WS_HMID && WS_HMID + (size_t)MROWS1 * 2816 * 2 <= WS_QRAW && WS_RAW + (size_t)MROWS1 * 4096 * 2 <= WS_QRAW &&
              WS_QRAW + (size_t)MROWS * 768 * 2 <= WS_KVRAW && WS_KVRAW + (size_t)MROWS1 * 1024 * 2 <= WS_KR && WS_KR + (size_t)MROWS1 * 256 * 2 <= WS_LOGF &&
              WS_LOGF + (size_t)MROWS1 * 32 <= WS_SS1P && WS_SS1P + (size_t)MROWS1 * 64 <= WS_SS2P && WS_SS2P + (size_t)MROWS1 * 64 <= WS_END &&
              WS_T + (size_t)MROWS * 1024 * 2 <= WS_MIX && WS_MIX + (size_t)MROWS * 1024 * 2 <= WS_LOGF && WS_AM + (size_t)MROWS * 512 * 2 <= WS_HMID, "d_ws map");

#define XB_TMO      128
#define XB_XCNT(j)  (256  + 64 * (j))
#define XB_XSUB(j)  (1280 + 64 * (j))
#define XB_XGEN(j)  (2304 + 64 * (j))
#define XB_TOP      3328
#define XB_TOPGEN   3392
#define XCD_BAR_WORDS 3456
#define XB_SPIN_CAP (1u << 18)

__device__ __forceinline__ unsigned xb_ld(unsigned* p)              { return __hip_atomic_load(p, __ATOMIC_RELAXED, __HIP_MEMORY_SCOPE_AGENT); }
__device__ __forceinline__ unsigned xb_add(unsigned* p, unsigned v) { return __hip_atomic_fetch_add(p, v, __ATOMIC_RELAXED, __HIP_MEMORY_SCOPE_AGENT); }
__device__ __forceinline__ unsigned xb_xcc_id() { return (unsigned)__builtin_amdgcn_s_getreg((3 << 11) | 20) & 0xFu; }
#define XB_SPIN(cond, bar) do { unsigned _sp = 0; while (cond) { __builtin_amdgcn_s_sleep(1); \
    if ((++_sp & 255u) == 0u) { if (xb_ld(&(bar)[XB_TMO])) break; if (_sp > XB_SPIN_CAP) { atomicAdd(&(bar)[XB_TMO], 1u); break; } } } } while (0)

struct XcdBarrier {
    unsigned* bar; unsigned x;
    volatile LAS unsigned* st;
};

__device__ __forceinline__ XcdBarrier xcd_barrier_post(unsigned* bar, volatile LAS unsigned* st) {
    XcdBarrier b; b.bar = bar; b.x = xb_xcc_id(); b.st = st;
    if (threadIdx.x == 0) (void)xb_add(&bar[XB_XCNT(b.x)], 1u);
    return b;
}
__device__ __forceinline__ void xcd_barrier_complete(unsigned* bar, unsigned x, unsigned& nloc, unsigned& nx) {
    const unsigned G = gridDim.x * gridDim.y * gridDim.z;
    unsigned sum, cnt, mine, sp = 0u;
    for (;;) {
        sum = 0u; cnt = 0u; mine = 0u;
#pragma unroll
        for (unsigned j = 0; j < 16; ++j) { const unsigned c = xb_ld(&bar[XB_XCNT(j)]); sum += c; cnt += (c > 0u) ? 1u : 0u; mine = (j == x) ? c : mine; }
        if (sum == G) break;
        __builtin_amdgcn_s_sleep(1);
        if ((++sp & 255u) == 0u) { if (xb_ld(&bar[XB_TMO])) break; if (sp > XB_SPIN_CAP) { atomicAdd(&bar[XB_TMO], 1u); break; } }
    }
    nloc = mine > 0u ? mine : 1u; nx = cnt > 0u ? cnt : 1u;
}

__device__ __forceinline__ void xcd_barrier(const XcdBarrier& b) {
    asm volatile("s_waitcnt vmcnt(0)" ::: "memory");
    __syncthreads();
    if (threadIdx.x == 0) {
        unsigned* bar = b.bar;
        __builtin_amdgcn_s_waitcnt(0);
        unsigned nloc = b.st[0], nx = b.st[1];
        if (nloc == 0u) { xcd_barrier_complete(bar, b.x, nloc, nx); b.st[0] = nloc; b.st[1] = nx; }
        const unsigned old = xb_add(&bar[XB_XSUB(b.x)], 1u);
        const unsigned gen = old / nloc;
        if (old + 1u == (gen + 1u) * nloc) {
            __builtin_amdgcn_fence(__ATOMIC_RELEASE, "agent");
            asm volatile("s_waitcnt vmcnt(0)" ::: "memory");
            const unsigned og = xb_add(&bar[XB_TOP], 1u);
            const unsigned tg = og / nx;
            if (og + 1u == (tg + 1u) * nx) xb_add(&bar[XB_TOPGEN], 1u);
            else XB_SPIN(xb_ld(&bar[XB_TOPGEN]) == tg, bar);
            __builtin_amdgcn_fence(__ATOMIC_ACQUIRE, "agent");
            xb_add(&bar[XB_XGEN(b.x)], 1u);
            asm volatile("s_waitcnt vmcnt(0)" ::: "memory");
        } else {
            XB_SPIN(xb_ld(&bar[XB_XGEN(b.x)]) == gen, bar);
            __builtin_amdgcn_fence(__ATOMIC_ACQUIRE, "agent");
            asm volatile("s_waitcnt vmcnt(0)" ::: "memory");
        }
    }
    __syncthreads();
}

struct Args { const float* in[23]; float* out; unsigned char* ws; int ph_lo, ph_hi; };
static_assert(sizeof(Args) == 26 * 8, "Args has no padding");

__device__ __forceinline__ unsigned f2bf(float f) { unsigned u = __builtin_bit_cast(unsigned, f); return (u + 0x7fffu + ((u >> 16) & 1u)) >> 16; }
__device__ __forceinline__ unsigned pk2(float lo, float hi) { return f2bf(lo) | (f2bf(hi) << 16); }
__device__ __forceinline__ float bflo(unsigned w) { return __uint_as_float(w << 16); }
__device__ __forceinline__ float bfhi(unsigned w) { return __uint_as_float(w & 0xffff0000u); }
__device__ __forceinline__ float wave_sum(float v) {
#pragma unroll
    for (int o = 1; o < 64; o <<= 1) v += __shfl_xor(v, o);
    return v;
}
__device__ __forceinline__ void tr_item(const float* W, int ldw, int scol0, int nvalid, const float* gain, bf16* WT, int K, int drow0, int k0, LAS float* scr, int lane) {
    const int ng = lane & 7, kr = lane >> 3;
#pragma unroll
    for (int i = 0; i < 8; ++i) { const int kk = 8 * i + kr; f32x4 v = (f32x4){0.f, 0.f, 0.f, 0.f};
        if (4 * ng < nvalid) { v = *(const f32x4*)(W + (size_t)(k0 + kk) * ldw + scol0 + 4 * ng); if (gain) v = v * gain[k0 + kk]; }
        scr[kk * 33 + 4 * ng] = v[0]; scr[kk * 33 + 4 * ng + 1] = v[1]; scr[kk * 33 + 4 * ng + 2] = v[2]; scr[kk * 33 + 4 * ng + 3] = v[3]; }
    asm volatile("s_waitcnt lgkmcnt(0)" ::: "memory");
    const int c = lane & 7;
#pragma unroll
    for (int j = 0; j < 4; ++j) { const int n = (lane >> 3) + 8 * j; const LAS float* s = scr + (8 * c) * 33 + n;
        v4u o; o.x = pk2(s[0 * 33], s[1 * 33]); o.y = pk2(s[2 * 33], s[3 * 33]); o.z = pk2(s[4 * 33], s[5 * 33]); o.w = pk2(s[6 * 33], s[7 * 33]);
        *(v4u*)(WT + (size_t)(drow0 + n) * K + k0 + 8 * c) = o; }
    asm volatile("s_waitcnt lgkmcnt(0)" ::: "memory");
}
typedef short sk_bf16x8 __attribute__((ext_vector_type(8)));
template <int NB> __device__ __forceinline__ void skinny16(const bf16* A, int lda, const bf16* Bt, int ldb, int K, const int (&brow)[NB], f32x4 (&acc)[NB], int lane) {
    const bf16* ap = A + (size_t)(lane & 15) * lda + 8 * (lane >> 4);
    const bf16* bp[NB];
#pragma unroll
    for (int b = 0; b < NB; ++b) { bp[b] = Bt + (size_t)(brow[b] + (lane & 15)) * ldb + 8 * (lane >> 4); acc[b] = (f32x4){0.f, 0.f, 0.f, 0.f}; }
#pragma unroll 4
    for (int k0 = 0; k0 < K; k0 += 32) {
        const sk_bf16x8 a = *(const sk_bf16x8*)(ap + k0);
#pragma unroll
        for (int b = 0; b < NB; ++b) { const sk_bf16x8 bb = *(const sk_bf16x8*)(bp[b] + k0); acc[b] = __builtin_amdgcn_mfma_f32_16x16x32_bf16(a, bb, acc[b], 0, 0, 0); }
    }
}
template <int NB> __device__ __forceinline__ void skinny16_wg(LAS unsigned char* lds, const bf16* A, int lda, const bf16* Bt, int ldb, int K, const int (&brow)[NB], f32x4 (&acc)[NB], int lane, int wave) {
    const int kper = K / 8;
    skinny16<NB>(A + wave * kper, lda, Bt + wave * kper, ldb, kper, brow, acc, lane);
    LAS f32x4* red = (LAS f32x4*)lds;
#pragma unroll
    for (int b = 0; b < NB; ++b) red[(wave * NB + b) * 64 + lane] = acc[b];
    __syncthreads();
    if (wave == 0) {
#pragma unroll
        for (int w = 1; w < 8; ++w)
#pragma unroll
            for (int b = 0; b < NB; ++b) acc[b] = acc[b] + red[(w * NB + b) * 64 + lane];
    }
    __syncthreads();
}
__device__ __forceinline__ float ss16(const float* p, int row) { float s = 0.f;
#pragma unroll
    for (int i = 0; i < 4; ++i) { const f32x4 v = *(const f32x4*)(p + (size_t)row * 16 + 4 * i); s += (v[0] + v[1]) + (v[2] + v[3]); }
    return s; }

__global__ void __launch_bounds__(NWAVES * 64, 2) fwd_kernel(Args args) {
    extern __shared__ __attribute__((aligned(16))) unsigned char lds_raw[];
    LAS unsigned char* lds = (LAS unsigned char*)lds_raw;
    const int tid = threadIdx.x, lane = tid & 63, wave = __builtin_amdgcn_readfirstlane(tid >> 6);
    const int G = gridDim.x, bx = blockIdx.x;
    volatile LAS unsigned* barst = (volatile LAS unsigned*)(lds + RING_BYTES + 64);
    if (tid < 2) barst[tid] = 0u;
    __syncthreads();
    XcdBarrier xbar; xbar.bar = (unsigned*)(args.ws + WS_BAR); xbar.x = 0; xbar.st = barst;
    unsigned char* ws = args.ws;
    const float* x = args.in[0]; const float* meta = args.in[1];
    float* out = args.out;
    float *SS0 = (float*)(ws + WS_SS0), *SS1 = (float*)(ws + WS_SS1P), *SS2 = (float*)(ws + WS_SS2P), *SSCQ = (float*)(ws + WS_SSCQ), *SSCKV = (float*)(ws + WS_SSCKV), *ROPE = (float*)(ws + WS_ROPE);
    bf16 *WGU1 = (bf16*)(ws + WS_WGU1), *WD1 = (bf16*)(ws + WS_WD1), *WGU2 = (bf16*)(ws + WS_WGU2), *WD2 = (bf16*)(ws + WS_WD2), *WIN = (bf16*)(ws + WS_WIN), *WUQ = (bf16*)(ws + WS_WUQ),
         *WUKV = (bf16*)(ws + WS_WUKV), *WBF = (bf16*)(ws + WS_WBF), *WBM = (bf16*)(ws + WS_WBM), *WOUT = (bf16*)(ws + WS_WOUT);
    bf16 *AB = (bf16*)(ws + WS_AB), *AF = (bf16*)out, *AM = (bf16*)out + (size_t)MROWS * 512,
         *HMID = (bf16*)(ws + WS_HMID), *RAW = (bf16*)(ws + WS_RAW), *QRAW = (bf16*)(ws + WS_QRAW);
    bf16 *KVRAW = (bf16*)(ws + WS_KVRAW), *KR = (bf16*)(ws + WS_KR), *MIX = (bf16*)(ws + WS_MIX), *TT = (bf16*)(ws + WS_T);
    float *LOGF = (float*)(ws + WS_LOGF);
    const int lo = args.ph_lo, hi = args.ph_hi;
#ifndef SKIP_MASK
#define SKIP_MASK 0
#endif
#define IN(k) (lo <= (k) && (k) < hi)
#define RUN(k) (IN(k) && !((SKIP_MASK >> (k)) & 1))
#ifndef REPEAT_MASK
#define REPEAT_MASK 0
#endif
#define NREP(k) (((REPEAT_MASK >> (k)) & 1) ? 2 : 1)
#define SEAM(k) do { if (IN(k) && IN((k) + 1)) { if ((k) == 0) { cg::this_grid().sync(); xbar = xcd_barrier_post((unsigned*)(args.ws + WS_BAR), barst); } else { xcd_barrier(xbar); } } } while (0)
    const int gw = bx * NWAVES + wave, NGW = G * NWAVES;
#define RS_FILL(S_, SSP_) do { LAS int* pml_ = (LAS int*)(lds + RING_BYTES + 512); LAS float* rsl_ = (LAS float*)(lds + RING_BYTES + 1024); \
        if (tid == 0) { int cnt_ = 0; pg8::Unit u_; for (int i_ = 0; (S_).next(i_, u_); ++i_) { bool seen_ = false; for (int k_ = 0; k_ < cnt_; ++k_) seen_ = seen_ || (pml_[k_] == u_.pm); \
            if (!seen_ && cnt_ < 8) pml_[cnt_++] = u_.pm; } pml_[8] = cnt_; } \
        __syncthreads(); \
        { const int cnt_ = pml_[8]; for (int idx_ = tid; idx_ < cnt_ * 256; idx_ += NWAVES * 64) { const int row_ = pml_[idx_ >> 8] * 256 + (idx_ & 255); rsl_[idx_] = rsqrtf(ss16((SSP_), row_) * (1.f / 1024.f) + EPS); } } \
        __syncthreads(); } while (0)
#define RS_TABLE(SSP_) epi::RsTable{(const LAS float*)(lds + RING_BYTES + 1024), (const LAS int*)(lds + RING_BYTES + 512), ((const LAS int*)(lds + RING_BYTES + 512))[8], (SSP_)}
    constexpr int C_FQ = 0, C_FK = 512, C_FV = 1024, C_FL = 1536, C_CQ = 1544, C_CKV = 1800, C_KR = 1928, C_GATE = 1960;

    if (RUN(0)) {
        if (bx == 0) for (int i = tid; i < XCD_BAR_WORDS; i += NWAVES * 64) ((unsigned*)(ws + WS_BAR))[i] = 0u;
        for (int i = bx * 512 + tid; i < 2064 * 16; i += G * 512) { const int pos = i >> 4, fi = i & 15;
            const float invf = __builtin_amdgcn_exp2f(-(float)fi * 0.8304820237218406f);
            const double rev = (double)((float)pos * invf) * 0.15915494309189535; const float fr = (float)(rev - floor(rev));
            ROPE[2 * i] = __builtin_amdgcn_cosf(fr); ROPE[2 * i + 1] = __builtin_amdgcn_sinf(fr); }
        LAS float* scr = (LAS float*)(lds + wave * 16384);
        constexpr int I_GU = 176 * 16, I_D = 32 * 44, I_WIN = 128 * 16, I_UQ = 24 * 4, I_UKV = 32 * 4, I_B = 32 * 8, I_OUT = 32 * 16;
        constexpr int NITEMS = 2 * I_GU + 2 * I_D + I_WIN + I_UQ + I_UKV + 2 * I_B + I_OUT;
        for (int it = gw; it < NITEMS; it += NGW) {
            int r = it;
            if (r < 2 * I_GU) { const int l = r / I_GU; r -= l * I_GU; const int rb = r / 16, kb = r % 16; const int pn = rb >> 3, bj = (rb >> 2) & 1, q = rb & 3;
                tr_item(args.in[l ? 21 : 3], 5632, bj * 2816 + pn * 128 + q * 32, 32, args.in[l ? 20 : 2], l ? WGU2 : WGU1, 1024, rb * 32, kb * 64, scr, lane); continue; } r -= 2 * I_GU;
            if (r < 2 * I_D) { const int l = r / I_D; r -= l * I_D; const int rb = r / 44, kb = r % 44;
                tr_item(args.in[l ? 22 : 4], 1024, rb * 32, 32, nullptr, l ? WD2 : WD1, 2816, rb * 32, kb * 64, scr, lane); continue; } r -= 2 * I_D;
            if (r < I_WIN) { const int rb = r / 16, kb = r % 16; const int nv = (rb * 32 + 32 <= 4008) ? 32 : ((rb * 32 < 4008) ? 4008 - rb * 32 : 0);
                tr_item(args.in[6], 4008, rb * 32, nv, args.in[5], WIN, 1024, rb * 32, kb * 64, scr, lane); continue; } r -= I_WIN;
            if (r < I_UQ) { const int rb = r / 4, kb = r % 4; tr_item(args.in[12], 768, rb * 32, 32, args.in[11], WUQ, 256, rb * 32, kb * 64, scr, lane); continue; } r -= I_UQ;
            if (r < I_UKV) { const int rb = r / 4, kb = r % 4;
                tr_item(args.in[14], 1024, rb * 32, kb < 2 ? 32 : 0, args.in[13], WUKV, 256, rb * 32, kb * 64, scr, lane); continue; } r -= I_UKV;
            if (r < 2 * I_B) { const int l = r / I_B; r -= l * I_B; const int rb = r / 8, kb = r % 8;
                tr_item(args.in[l ? 18 : 17], 1024, rb * 32, 32, nullptr, l ? WBM : WBF, 512, rb * 32, kb * 64, scr, lane); continue; } r -= 2 * I_B;
            { const int rb = r / 16, kb = r % 16; tr_item(args.in[19], 1024, rb * 32, 32, nullptr, WOUT, 1024, rb * 32, kb * 64, scr, lane); }
        }
        for (int m0 = 2 * gw; m0 < MROWS + NMETA; m0 += 2 * NGW) {
            f32x4 v[2][4];
#pragma unroll
            for (int q = 0; q < 2; ++q) { const int m = m0 + q; const float* src = (m < MROWS) ? x + (size_t)m * 1024 : meta + (size_t)(m - MROWS) * 1024;
#pragma unroll
                for (int j = 0; j < 4; ++j) v[q][j] = *((const f32x4*)src + lane + 64 * j); }
#pragma unroll
            for (int q = 0; q < 2; ++q) { float s = 0.f;
#pragma unroll
                for (int j = 0; j < 4; ++j) s += (v[q][j][0] * v[q][j][0] + v[q][j][1] * v[q][j][1]) + (v[q][j][2] * v[q][j][2] + v[q][j][3] * v[q][j][3]);
                s = wave_sum(s); if (lane == 0) SS0[m0 + q] = s;
                const float rs0 = rsqrtf(s * (1.f / 1024.f) + EPS);
                v2u* o8 = (v2u*)(AB + (size_t)(m0 + q) * 1024) + lane;
#pragma unroll
                for (int j = 0; j < 4; ++j) { const f32x4 t = v[q][j] * rs0; v2u o; o.x = pk2(t[0], t[1]); o.y = pk2(t[2], t[3]); o8[64 * j] = o; }
            }
        }
    }
    SEAM(0);
    if (RUN(1)) {
        if (bx < 176) {
            const int pn = bx >> 3, jb = bx & 7; const int brow[2] = {256 * pn + 16 * jb, 256 * pn + 128 + 16 * jb}; f32x4 acc[2];
            skinny16_wg<2>(lds, AB + (size_t)MROWS * 1024, 1024, WGU1, 1024, 1024, brow, acc, lane, wave);
            if (wave == 0)
#pragma unroll
            for (int j = 0; j < 4; ++j) { const int row = MROWS + 4 * (lane >> 4) + j;
                const float gg = acc[0][j], uu = acc[1][j]; const float hv = gg * epi::sigm(gg) * uu;
                HMID[(size_t)row * 2816 + 128 * pn + 16 * jb + (lane & 15)] = (bf16)f2bf(hv); }
        }
        pg8::Gemm g{AB, WGU1, MROWS, 5632, 1024, 1024}; pg8::StaticOrder S; S.init(MROWS, 5632, G, bx);
        epi::EpiSwiglu<0> E{HMID, 2816, SS0, {}}; pg8::gemm_phase<epi::EpiSwiglu<0>, pg8::StaticOrder, true, true>(lds, g, S, E); }
    SEAM(1);
    if (RUN(2)) {
        if (bx < 16) {
            const int brow[4] = {64 * bx, 64 * bx + 16, 64 * bx + 32, 64 * bx + 48}; f32x4 acc[4];
            skinny16_wg<4>(lds, HMID + (size_t)MROWS * 2816, 2816, WD1, 2816, 2816, brow, acc, lane, wave);
            if (wave == 0)
#pragma unroll
            for (int j = 0; j < 4; ++j) { const int r16 = 4 * (lane >> 4) + j; float sq = 0.f;
#pragma unroll
                for (int b = 0; b < 4; ++b) { const int col = 64 * bx + 16 * b + (lane & 15); const float v = meta[(size_t)r16 * 1024 + col] + 0.5f * acc[b][j];
                    AB[(size_t)(MROWS + r16) * 1024 + col] = (bf16)f2bf(v); sq += v * v; }
                sq += __shfl_xor(sq, 1); sq += __shfl_xor(sq, 2); sq += __shfl_xor(sq, 4); sq += __shfl_xor(sq, 8);
                if ((lane & 15) == 0) SS1[(size_t)(MROWS + r16) * 16 + bx] = sq; }
        }
        pg8::Gemm g{HMID, WD1, MROWS, 1024, 2816, 2816}; pg8::StaticOrder S; S.init(MROWS, 1024, G, bx);
        epi::EpiRes<true, false, false, true, true> E{x, nullptr, nullptr, AB, SS1}; pg8::gemm_phase<epi::EpiRes<true, false, false, true, true>, pg8::StaticOrder, true, true>(lds, g, S, E); }
    SEAM(2);
    if (RUN(3)) {
        if (bx < 91) {
            const int brow[1] = {512 + 16 * bx}; f32x4 acc[1];
            skinny16_wg<1>(lds, AB + (size_t)MROWS * 1024, 1024, WIN, 1024, 1024, brow, acc, lane, wave);
            if (wave == 0)
#pragma unroll
            for (int j = 0; j < 4; ++j) { const int row = MROWS + 4 * (lane >> 4) + j; const float rs = rsqrtf(ss16(SS1, row) * (1.f / 1024.f) + EPS);
                RAW[(size_t)row * 4096 + 512 + 16 * bx + (lane & 15)] = (bf16)f2bf(acc[0][j] * rs); }
        }
        pg8::Gemm g{AB, WIN, MROWS, 4096, 1024, 1024}; pg8::StaticOrder S; S.init(MROWS, 4096, G, bx);
        RS_FILL(S, SS1);
        epi::EpiRowScale<-1> E{RAW, 4096, SS1, 1.f / 1024.f, RS_TABLE(SS1)}; pg8::gemm_phase<epi::EpiRowScale<-1>, pg8::StaticOrder, true, true>(lds, g, S, E); }
    SEAM(3);
    if (RUN(4)) {
        const float* gfq = args.in[9]; const float* gfk = args.in[10]; const float* bfor = args.in[7];
        const int hd16 = lane >> 2, sub = lane & 3;
        for (int row0 = 2 * gw; row0 < MROWS + NMETA; row0 += 2 * NGW) {
            v4u a[2], b[2]; v2u c[2]; unsigned d[2]; unsigned short fl[2];
#pragma unroll
            for (int q = 0; q < 2; ++q) { const bf16* rp = RAW + (size_t)(row0 + q) * 4096; const bf16* p = rp + hd16 * 64 + sub * 16;
                a[q] = *(const v4u*)p; b[q] = *(const v4u*)(p + 8); c[q] = *(const v2u*)(rp + C_CQ + 4 * lane); d[q] = *(const unsigned*)(rp + C_CKV + 2 * lane); fl[q] = rp[C_FL + (lane & 7)]; }
#pragma unroll
            for (int q = 0; q < 2; ++q) { const int row = row0 + q; bf16* rp = RAW + (size_t)row * 4096; bf16* p = rp + hd16 * 64 + sub * 16;
              { float v[16];
                v[0] = bflo(a[q].x); v[1] = bfhi(a[q].x); v[2] = bflo(a[q].y); v[3] = bfhi(a[q].y); v[4] = bflo(a[q].z); v[5] = bfhi(a[q].z); v[6] = bflo(a[q].w); v[7] = bfhi(a[q].w);
                v[8] = bflo(b[q].x); v[9] = bfhi(b[q].x); v[10] = bflo(b[q].y); v[11] = bfhi(b[q].y); v[12] = bflo(b[q].z); v[13] = bfhi(b[q].z); v[14] = bflo(b[q].w); v[15] = bfhi(b[q].w);
                float s = 0.f;
#pragma unroll
                for (int i = 0; i < 16; ++i) s += v[i] * v[i];
                s += __shfl_xor(s, 1); s += __shfl_xor(s, 2);
                const float* gn = (hd16 < 8 ? gfq : gfk) + sub * 16;
                const float rr = rsqrtf(s * (1.f / 64.f) + EPS) * (hd16 < 8 ? 0.125f * L2E : 1.f);
#pragma unroll
                for (int i = 0; i < 16; ++i) v[i] = v[i] * rr * gn[i];
                v4u oa, ob; oa.x = pk2(v[0], v[1]); oa.y = pk2(v[2], v[3]); oa.z = pk2(v[4], v[5]); oa.w = pk2(v[6], v[7]);
                ob.x = pk2(v[8], v[9]); ob.y = pk2(v[10], v[11]); ob.z = pk2(v[12], v[13]); ob.w = pk2(v[14], v[15]);
                *(v4u*)p = oa; *(v4u*)(p + 8) = ob; }
              if (lane < 8) { const float z = __uint_as_float((unsigned)fl[q] << 16) + bfor[lane];
                LOGF[(size_t)row * 8 + lane] = fminf(z, 0.f) - log1pf(expf(-fabsf(z))); }
              { float s1 = bflo(c[q].x) * bflo(c[q].x) + bfhi(c[q].x) * bfhi(c[q].x) + bflo(c[q].y) * bflo(c[q].y) + bfhi(c[q].y) * bfhi(c[q].y);
                float s2 = bflo(d[q]) * bflo(d[q]) + bfhi(d[q]) * bfhi(d[q]);
                s1 = wave_sum(s1); s2 = wave_sum(s2);
                if (lane == 0) { SSCQ[row] = s1; SSCKV[row] = s2; } }
            }
        }
    }
    SEAM(4);
    if (RUN(5)) {
        if (gw < 64) {
            const int brow[1] = {16 * gw}; f32x4 acc[1];
            skinny16<1>(RAW + (size_t)MROWS * 4096 + C_CKV, 4096, WUKV, 256, 128, brow, acc, lane);
#pragma unroll
            for (int j = 0; j < 4; ++j) { const int row = MROWS + 4 * (lane >> 4) + j; const float rs = rsqrtf(SSCKV[row] * (1.f / 128.f) + EPS);
                KVRAW[(size_t)row * 1024 + 16 * gw + (lane & 15)] = (bf16)f2bf(acc[0][j] * rs); }
        }
        { pg8::Gemm g{RAW + C_CQ, WUQ, MROWS, 768, 256, 4096}; pg8::StaticOrder S; S.init(MROWS, 768, G, bx);
          epi::EpiRowScale<1> E{QRAW, 768, SSCQ, 1.f / 256.f, {}}; pg8::gemm_phase<epi::EpiRowScale<1>, pg8::StaticOrder, true, true>(lds, g, S, E); }
        { pg8::Gemm g{RAW + C_CKV, WUKV, MROWS, 1024, 256, 4096}; pg8::StaticOrder S; S.init(MROWS, 1024, G, bx);
          epi::EpiRowScale<1> E{KVRAW, 1024, SSCKV, 1.f / 128.f, {}}; pg8::gemm_phase<epi::EpiRowScale<1>, pg8::StaticOrder, true, true>(lds, g, S, E); }
    }
    SEAM(5);
    if (RUN(6)) {
        const float* gqn = args.in[15]; const float* gkn = args.in[16];
        const int hd = lane >> 3, sub = lane & 7;
        const float QS = 0.10206207261596577f * L2E;
        constexpr int NTOT = 2 * MROWS + NMETA;
        for (int m0 = gw; m0 < NTOT; m0 += 2 * NGW) {
            bool isq[2], val[2]; int row[2], pos[2]; v4u a[2]; unsigned b1[2], b2[2];
#pragma unroll
            for (int q = 0; q < 2; ++q) { const int m = m0 + q * NGW; val[q] = m < NTOT; const int mm = val[q] ? m : m0;
                isq[q] = mm < MROWS; row[q] = isq[q] ? mm : mm - MROWS; pos[q] = (row[q] < MROWS) ? NMETA + (row[q] & (SEQ - 1)) : row[q] - MROWS;
                if (isq[q]) { const bf16* p = QRAW + (size_t)row[q] * 768 + hd * 96; a[q] = *(const v4u*)(p + 8 * sub); b1[q] = *(const unsigned*)(p + 64 + 2 * sub); b2[q] = *(const unsigned*)(p + 80 + 2 * sub); }
                else { const bf16* p = KVRAW + (size_t)row[q] * 1024 + hd * 128; const bf16* kr = RAW + (size_t)row[q] * 4096 + C_KR;
                    a[q] = *(const v4u*)(p + 8 * sub); b1[q] = *(const unsigned*)(kr + 2 * sub); b2[q] = *(const unsigned*)(kr + 16 + 2 * sub); } }
#pragma unroll
            for (int q = 0; q < 2; ++q) {
                float nv[8], x1[2], x2[2];
                nv[0] = bflo(a[q].x); nv[1] = bfhi(a[q].x); nv[2] = bflo(a[q].y); nv[3] = bfhi(a[q].y); nv[4] = bflo(a[q].z); nv[5] = bfhi(a[q].z); nv[6] = bflo(a[q].w); nv[7] = bfhi(a[q].w);
                x1[0] = bflo(b1[q]); x1[1] = bfhi(b1[q]); x2[0] = bflo(b2[q]); x2[1] = bfhi(b2[q]);
                float s = x1[0] * x1[0] + x1[1] * x1[1] + x2[0] * x2[0] + x2[1] * x2[1];
#pragma unroll
                for (int i = 0; i < 8; ++i) s += nv[i] * nv[i];
                s += __shfl_xor(s, 1); s += __shfl_xor(s, 2); s += __shfl_xor(s, 4);
                const float* gn = isq[q] ? gqn : gkn;
                const float rr = rsqrtf(s * (1.f / 96.f) + EPS) * (isq[q] ? QS : 1.f);
                v4u o; float t8[8];
#pragma unroll
                for (int i = 0; i < 8; ++i) t8[i] = nv[i] * rr * gn[8 * sub + i];
                o.x = pk2(t8[0], t8[1]); o.y = pk2(t8[2], t8[3]); o.z = pk2(t8[4], t8[5]); o.w = pk2(t8[6], t8[7]);
                float r1[2], r2[2];
#pragma unroll
                for (int i = 0; i < 2; ++i) { const int fi = 2 * sub + i; const float cs = ROPE[(pos[q] * 16 + fi) * 2], sn = ROPE[(pos[q] * 16 + fi) * 2 + 1];
                    const float aa = x1[i] * rr * gn[64 + fi], bb = x2[i] * rr * gn[80 + fi]; r1[i] = aa * cs - bb * sn; r2[i] = aa * sn + bb * cs; }
                if (val[q]) {
                    if (isq[q]) { bf16* p = QRAW + (size_t)row[q] * 768 + hd * 96; *(v4u*)(p + 8 * sub) = o; *(unsigned*)(p + 64 + 2 * sub) = pk2(r1[0], r1[1]); *(unsigned*)(p + 80 + 2 * sub) = pk2(r2[0], r2[1]); }
                    else { bf16* p = KVRAW + (size_t)row[q] * 1024 + hd * 128; *(v4u*)(p + 8 * sub) = o; bf16* qq = KR + (size_t)row[q] * 256 + hd * 32; *(unsigned*)(qq + 2 * sub) = pk2(r1[0], r1[1]); *(unsigned*)(qq + 16 + 2 * sub) = pk2(r2[0], r2[1]); }
                }
            }
        }
    }
    SEAM(6);
    if (RUN(7)) for (int rep = 0; rep < NREP(7); ++rep) {
        for (int u = bx; u < 256; u += G) { const int b = u >> 3, h = u & 7;
            attn::Tensors T{RAW, 4096, C_FQ + h * 64, RAW, 4096, C_FK + h * 64, C_FV + h * 64, RAW, 4096, 0, AF, 512, h * 64, LOGF, h, args.in[9], args.in[10]};
            attn::attn_bh<64, true>(lds, T, b); }
        for (int u = bx; u < 256; u += G) { const int b = u >> 3, h = u & 7;
            attn::Tensors T{QRAW, 768, h * 96, KVRAW, 1024, h * 128, h * 128 + 64, KR, 256, h * 32, AM, 512, h * 64, nullptr, 0, nullptr, nullptr};
            attn::attn_bh<96, false>(lds, T, b); }
    }
    SEAM(7);
    if (RUN(8)) {
        { pg8::Gemm g{AF, WBF, MROWS, 1024, 512, 512}; pg8::StaticOrder S; S.init(MROWS, 1024, G, bx);
          epi::EpiGate<0> E{TT, MIX, RAW, args.in[8], C_GATE}; pg8::gemm_phase<epi::EpiGate<0>, pg8::StaticOrder, true, true>(lds, g, S, E); }
        { pg8::Gemm g{AM, WBM, MROWS, 1024, 512, 512}; pg8::StaticOrder S; S.init(MROWS, 1024, G, bx);
          epi::EpiGate<1> E{TT, MIX, RAW, args.in[8] + 1024, C_GATE + 1024}; pg8::gemm_phase<epi::EpiGate<1>, pg8::StaticOrder, true, true>(lds, g, S, E); }
    }
    SEAM(8);
    if (RUN(9)) { pg8::Gemm g{MIX, WOUT, MROWS, 1024, 1024, 1024}; pg8::StaticOrder S; S.init(MROWS, 1024, G, bx);
        epi::EpiRes<false, true, false, true, true> E{nullptr, AB, nullptr, AB, SS2}; pg8::gemm_phase<epi::EpiRes<false, true, false, true, true>, pg8::StaticOrder, true, true>(lds, g, S, E); }
    SEAM(9);
    if (RUN(10)) { pg8::Gemm g{AB, WGU2, MROWS, 5632, 1024, 1024}; pg8::StaticOrder S; S.init(MROWS, 5632, G, bx);
        RS_FILL(S, SS2);
        epi::EpiSwiglu<-1> E{HMID, 2816, SS2, RS_TABLE(SS2)}; pg8::gemm_phase<epi::EpiSwiglu<-1>, pg8::StaticOrder, true, true>(lds, g, S, E); }
    SEAM(10);
    if (RUN(11)) { pg8::Gemm g{HMID, WD2, MROWS, 1024, 2816, 2816}; pg8::StaticOrder S; S.init(MROWS, 1024, G, bx);
        epi::EpiRes<true, true, true, false, false> E{nullptr, AB, out, nullptr, nullptr}; pg8::gemm_phase<epi::EpiRes<true, true, true, false, false>, pg8::StaticOrder, true, true>(lds, g, S, E); }
#if defined(DUMP_MIB)
    cg::this_grid().sync();
    { const size_t n = (size_t)MROWS * 1024; const unsigned char* src = ws + (size_t)DUMP_MIB * MiB;
      for (size_t i = (size_t)bx * 512 + tid; i < n; i += (size_t)G * 512)
          out[i] = DUMP_F32 ? ((const float*)src)[i] : __uint_as_float((unsigned)((const bf16*)src)[i] << 16); }
#endif
#undef IN
#undef SEAM
}

extern "C" void kernel_launch(void* const* d_in, const int* in_sizes, int n_in, void* d_out, int out_size, void* d_ws, size_t ws_size, hipStream_t stream) {
    static int grid = 0;
    if (grid == 0) {
        if (n_in != 23 || out_size != MROWS * 1024 || ws_size < WS_END) { fprintf(stderr, "kernel_launch: unexpected shapes (n_in %d out %d ws %zu)\n", n_in, out_size, ws_size); grid = -1; return; }
        int dev = 0, cus = 0, per_cu = 0;
        (void)hipGetDevice(&dev); (void)hipDeviceGetAttribute(&cus, hipDeviceAttributeMultiprocessorCount, dev);
        if (hipFuncSetAttribute((const void*)fwd_kernel, hipFuncAttributeMaxDynamicSharedMemorySize, LDS_BYTES) != hipSuccess) { fprintf(stderr, "kernel_launch: hipFuncSetAttribute failed\n"); grid = -1; return; }
        if (hipOccupancyMaxActiveBlocksPerMultiprocessor(&per_cu, (const void*)fwd_kernel, NWAVES * 64, LDS_BYTES) != hipSuccess || per_cu < 1) { fprintf(stderr, "kernel_launch: occupancy query says %d\n", per_cu); per_cu = 1; }
        (void)hipGetLastError();
        grid = cus > 0 ? cus : 256;
    }
    if (grid < 0) return;
    Args a{};
    for (int i = 0; i < 23; ++i) a.in[i] = (const float*)d_in[i];
    a.out = (float*)d_out; a.ws = (unsigned char*)d_ws;
#if MK_N_LAUNCHES == 1
    a.ph_lo = 0; a.ph_hi = NPHASE;
    void* kargs[] = {&a};
    hipError_t e = hipLaunchCooperativeKernel((const void*)fwd_kernel, dim3(grid), dim3(NWAVES * 64), kargs, LDS_BYTES, stream);
    if (e != hipSuccess) fprintf(stderr, "kernel_launch: cooperative launch failed: %s (grid %d)\n", hipGetErrorString(e), grid);
#else
    for (int p = 0; p < NPHASE; ++p) { a.ph_lo = p; a.ph_hi = p + 1;
        hipLaunchKernelGGL(fwd_kernel, dim3(grid), dim3(NWAVES * 64), LDS_BYTES, stream, a); }
#endif
}
```
